# Optimizing an MI355X kernel written in HIP

```python
import math
import jax
import jax.numpy as jnp
from jax import lax
import numpy as np

D_MODEL = 1024
BATCH = 4
SEQ = 8192
DEPTH = 4

CTX_LEN = 256
GRID_W = 64
N_EVEN = (DEPTH + 1) // 2
N_ODD = DEPTH // 2
N_MOD = 9
NORM_EPS = 1e-6
D_FF = 2816

RWKV_HEAD_DIM = 64
RWKV_HEADS = D_MODEL // 128
RWKV_WIDTH = RWKV_HEADS * RWKV_HEAD_DIM
DECAY_LORA = 64
ICLR_LORA = 64
GATE_LORA = 128
RWKV_SPLITS = (RWKV_WIDTH, 2 * RWKV_WIDTH, 3 * RWKV_WIDTH, 3 * RWKV_WIDTH + 2 * DECAY_LORA, 3 * RWKV_WIDTH + 2 * DECAY_LORA + 2 * ICLR_LORA)
RWKV_COLS = RWKV_SPLITS[-1] + GATE_LORA
GN_EPS = 64e-5

S5_WIDTH = D_MODEL // 2
S5_GROUP = 16
S5_GROUPS = S5_WIDTH // S5_GROUP
S5_STATE = 64
DT_MIN = 1e-3
DT_MAX = 1e-1

EVEN_IN = RWKV_COLS + S5_WIDTH
EVEN_OUT = RWKV_WIDTH + S5_WIDTH

HY_WIDTH = D_MODEL
HY_ORDER = 2
HY_IN = (HY_ORDER + 1) * HY_WIDTH
HY_SHORT = 3
HY_EMB = 33
HY_BANDS = (HY_EMB - 1) // 2
HY_HIDDEN = 64
HY_MIN_DECAY = math.log(1e-2) / 1.5
HY_MAX_DECAY = math.log(1e-2) / 0.3

kernel_name = 'hybrid_rwkv7_s5_hyena_flow_trunk'


def rms_norm(x, gain):
    xf = x.astype(jnp.float32)
    y = xf * lax.rsqrt(jnp.mean(xf * xf, axis=-1, keepdims=True) + NORM_EPS)
    return (y * gain.astype(jnp.float32)).astype(x.dtype)


def modulate(x, gain, shift, scale):
    return rms_norm(x, gain) * (1 + scale) + shift


def ada_mods(cond, w, b):
    m = jax.nn.silu(cond) @ w + b
    m = m.reshape(m.shape[:-1] + (1, m.shape[-1]))
    return jnp.split(m, N_MOD, axis=-1)


def ffn_half(x, gain, shift, scale, gate, wg, wu, wd):
    h = modulate(x, gain, shift, scale)
    return x + 0.5 * gate * ((jax.nn.silu(h @ wg) * (h @ wu)) @ wd)


def shift_axis(x, offset, axis):
    n = x.shape[axis]
    pad = [(0, 0)] * x.ndim
    if offset > 0:
        pad[axis] = (offset, 0)
        kept = lax.slice_in_dim(x, 0, n - offset, axis=axis)
    else:
        pad[axis] = (0, -offset)
        kept = lax.slice_in_dim(x, -offset, n, axis=axis)
    return jnp.pad(kept, pad)


def qshift_latent(p):
    bsz, L, C = p.shape
    rows = L // GRID_W
    g = p.reshape(bsz, rows, GRID_W, C // 4, 4)
    parts = [shift_axis(g[..., 0], 1, 2), shift_axis(g[..., 1], -1, 2),
             shift_axis(g[..., 2], 1, 1), shift_axis(g[..., 3], -1, 1)]
    return jnp.stack(parts, axis=-1).reshape(bsz, L, C)


def qshift_context(p):
    bsz, L, C = p.shape
    g = p.reshape(bsz, L, C // 4, 4)
    parts = [shift_axis(g[..., 0], 1, 1), shift_axis(g[..., 1], -1, 1),
             shift_axis(g[..., 2], 1, 1), shift_axis(g[..., 3], -1, 1)]
    return jnp.stack(parts, axis=-1).reshape(bsz, L, C)


def rwkv_features(p, shifted, mu, w0, w_up, a0, a_up, g_up, k_k, k_a):
    f32 = jnp.float32
    q = (p + mu * (shifted - p)).astype(f32)
    bsz, L, _ = q.shape
    r, k, v, wd, ad, gd = jnp.split(q, RWKV_SPLITS, axis=-1)
    wd = wd.reshape(bsz, L, 2, DECAY_LORA)
    ad = ad.reshape(bsz, L, 2, ICLR_LORA)
    w_log = -jax.nn.softplus(-(w0 + jnp.einsum('blds,dsc->bldc', jnp.tanh(wd), w_up))) - 0.5
    decay = jnp.exp(-jnp.exp(w_log))
    a = jax.nn.sigmoid(a0 + jnp.einsum('blds,dsc->bldc', ad, a_up))
    g = jax.nn.sigmoid(gd) @ g_up

    def heads(t):
        return t.reshape(t.shape[:-1] + (RWKV_HEADS, RWKV_HEAD_DIM))

    kk = heads(k * k_k)
    kk = kk / jnp.maximum(jnp.sqrt(jnp.sum(kk * kk, axis=-1, keepdims=True)), 1e-12)
    k_dir = k[:, :, None] * (1 + (a - 1) * k_a)
    return heads(r), heads(v), kk, g, heads(decay), heads(k_dir), heads(a)


def rwkv_scan(r, w, k, v, kk, a, s0, reverse):
    def step(s, inp):
        r_t, w_t, k_t, v_t, kk_t, a_t = inp
        sa = jnp.einsum('bhij,bhj->bhi', s, kk_t)
        s = (s * w_t[:, :, None, :] - sa[..., None] * (kk_t * a_t)[:, :, None, :]
             + v_t[..., None] * k_t[:, :, None, :])
        return s, jnp.einsum('bhij,bhj->bhi', s, r_t)

    xs = tuple(jnp.moveaxis(t, 1, 0) for t in (r, w, k, v, kk, a))
    s_final, out = lax.scan(step, s0, xs, reverse=reverse)
    return jnp.moveaxis(out, 0, 1), s_final


def rwkv_readout(o_f, o_b, r, k_f, k_b, v, g, r_k, gn_g, gn_b):
    o = o_f + o_b
    mean = jnp.mean(o, axis=-1, keepdims=True)
    var = jnp.mean(jnp.square(o - mean), axis=-1, keepdims=True)
    o = (o - mean) * lax.rsqrt(var + GN_EPS)
    bonus = jnp.sum(r * (k_f + k_b) * r_k, axis=-1, keepdims=True) * v
    bsz, L = o.shape[:2]
    o = o.reshape(bsz, L, RWKV_WIDTH) * gn_g + gn_b + bonus.reshape(bsz, L, RWKV_WIDTH)
    return o * g


def s5_discretise(lam_re, lam_im, log_dt, b_re, b_im):
    f32 = jnp.float32
    lam = lax.complex(lam_re.astype(f32), lam_im.astype(f32))
    dt = jnp.exp(log_dt.astype(f32))[..., None]
    a_bar = jnp.exp(lam * dt)
    b_bar = ((a_bar - 1) / lam)[..., None] * lax.complex(b_re.astype(f32), b_im.astype(f32))
    return a_bar, b_bar


def s5_scan(u, a_bar, b_bar, h0, reverse):
    bu = jnp.einsum('gph,blgh->blgp', b_bar, u)
    idx = -1 if reverse else 0
    bu = bu.at[:, idx].add(a_bar[None] * h0)
    L = u.shape[1]
    a = jnp.broadcast_to(a_bar[None, None], (1, L) + a_bar.shape)

    def combine(e1, e2):
        a1, b1 = e1
        a2, b2 = e2
        return a2 * a1, a2 * b1 + b2

    _, h = lax.associative_scan(combine, (a, bu), reverse=reverse, axis=1)
    return h


def s5_readout(h_f, h_b, u, c_mat, d_skip, w_glu, b_glu):
    y = jnp.real(jnp.einsum('ghp,blgp->blgh', c_mat[0], h_f) + jnp.einsum('ghp,blgp->blgh', c_mat[1], h_b))
    bsz, L = u.shape[:2]
    y = y.reshape(bsz, L, S5_WIDTH) + d_skip * u.reshape(bsz, L, S5_WIDTH)
    y = jax.nn.gelu(y)
    return y * jax.nn.sigmoid(y @ w_glu + b_glu)


def even_mixer(h_lat, h_ctx, ctx_out, prm):
    (w_in, mu, w0, w_up, a0, a_up, g_up, k_k, k_a, r_k, gn_g, gn_b,
     lam_re, lam_im, log_dt, b_re, b_im, c_re, c_im, d_skip, w_glu, b_glu, w_out) = prm
    f32 = jnp.float32
    bsz = h_lat.shape[0]
    p_lat = h_lat @ w_in
    p_ctx = h_ctx @ w_in

    def rwkv_feats(p, shift_fn):
        pr = p[..., :RWKV_COLS]
        return rwkv_features(pr, shift_fn(pr), mu, w0, w_up, a0, a_up, g_up, k_k, k_a)

    r_c, v_c, kk_c, g_c, w_c, k_c, a_c = rwkv_feats(p_ctx, qshift_context)
    r_l, v_l, kk_l, g_l, w_l, k_l, a_l = rwkv_feats(p_lat, qshift_latent)
    s_zero = jnp.zeros((bsz, RWKV_HEADS, RWKV_HEAD_DIM, RWKV_HEAD_DIM), f32)
    oc_f, sc_f = rwkv_scan(r_c, w_c[:, :, 0], k_c[:, :, 0], v_c, kk_c, a_c[:, :, 0], s_zero, False)
    oc_b, sc_b = rwkv_scan(r_c, w_c[:, :, 1], k_c[:, :, 1], v_c, kk_c, a_c[:, :, 1], s_zero, True)
    ol_f, _ = rwkv_scan(r_l, w_l[:, :, 0], k_l[:, :, 0], v_l, kk_l, a_l[:, :, 0], sc_f, False)
    ol_b, _ = rwkv_scan(r_l, w_l[:, :, 1], k_l[:, :, 1], v_l, kk_l, a_l[:, :, 1], sc_b, True)

    a_bar, b_bar = s5_discretise(lam_re, lam_im, log_dt, b_re, b_im)
    c_mat = lax.complex(c_re.astype(f32), c_im.astype(f32))
    u_c = p_ctx[..., RWKV_COLS:].astype(f32).reshape(bsz, -1, S5_GROUPS, S5_GROUP)
    u_l = p_lat[..., RWKV_COLS:].astype(f32).reshape(bsz, -1, S5_GROUPS, S5_GROUP)
    h_zero = jnp.zeros((bsz, S5_GROUPS, S5_STATE), jnp.complex64)
    hc_f = s5_scan(u_c, a_bar[0], b_bar[0], h_zero, False)
    hc_b = s5_scan(u_c, a_bar[1], b_bar[1], h_zero, True)
    hl_f = s5_scan(u_l, a_bar[0], b_bar[0], hc_f[:, -1], False)
    hl_b = s5_scan(u_l, a_bar[1], b_bar[1], hc_b[:, 0], True)

    def merge(o_f, o_b, r, k, v, g, h_f, h_b, u):
        y_rwkv = rwkv_readout(o_f, o_b, r, k[:, :, 0], k[:, :, 1], v, g, r_k, gn_g, gn_b)
        y_s5 = s5_readout(h_f, h_b, u, c_mat, d_skip, w_glu, b_glu)
        return jnp.concatenate([y_rwkv, y_s5], axis=-1).astype(h_lat.dtype) @ w_out

    y_lat = merge(ol_f, ol_b, r_l, k_l, v_l, g_l, hl_f, hl_b, u_l)
    y_ctx = merge(oc_f, oc_b, r_c, k_c, v_c, g_c, hc_f, hc_b, u_c) if ctx_out else None
    return y_lat, y_ctx


def short_conv(p, w, b):
    return w[0] * shift_axis(p, 1, 1) + w[1] * p + w[2] * shift_axis(p, -1, 1) + b


def hyena_filter_spectrum(L, fw1, fb1, fw2, fb2, fw3, fb3, fw4, freq):
    f32 = jnp.float32
    pos = jnp.arange(L, dtype=f32)[:, None]
    t = pos / max(L - 1, 1)
    ang = 2 * math.pi * pos / L
    bands = jnp.linspace(1e-4, HY_BANDS - 1, HY_BANDS, dtype=f32)[None]
    feats = jnp.concatenate([t, jnp.cos(bands * ang), -jnp.sin(bands * ang)], axis=-1)
    fr = freq.astype(f32)
    hdn = jnp.sin(fr * (feats @ fw1.astype(f32) + fb1.astype(f32)))
    hdn = jnp.sin(fr * (hdn @ fw2.astype(f32) + fb2.astype(f32)))
    hdn = jnp.sin(fr * (hdn @ fw3.astype(f32) + fb3.astype(f32)))
    filt = (hdn @ fw4.astype(f32)).reshape(L, HY_ORDER, 2, HY_WIDTH)
    deltas = jnp.abs(jnp.linspace(HY_MIN_DECAY, HY_MAX_DECAY, HY_WIDTH, dtype=f32))
    filt = filt * jnp.exp(-t[:, :, None, None] * deltas)
    fwd, bwd = filt[:, :, 0], filt[:, :, 1]
    kern = jnp.concatenate([fwd, jnp.zeros_like(fwd[:1]), bwd[:0:-1]], axis=0)
    kern = kern * lax.rsqrt(jnp.sum(kern * kern, axis=0, keepdims=True) + 1e-6)
    return jnp.fft.rfft(kern, axis=0)


def hyena_mixer(h, prm):
    (w_in, conv_w, conv_b, fw1, fb1, fw2, fb2, fw3, fb3, fw4, freq, bias_d, w_out) = prm
    f32 = jnp.float32
    L = h.shape[1]
    p = short_conv(h @ w_in, conv_w, conv_b).astype(f32)
    parts = jnp.split(p, HY_ORDER + 1, axis=-1)
    kf = hyena_filter_spectrum(L, fw1, fb1, fw2, fb2, fw3, fb3, fw4, freq)
    z = parts[0]
    for n, gate in enumerate(parts[1:]):
        zf = jnp.fft.rfft(z, n=2 * L, axis=1)
        conv = jnp.fft.irfft(zf * kf[None, :, n], n=2 * L, axis=1)[:, :L]
        z = gate * (conv + bias_d[n] * z)
    return z.astype(h.dtype) @ w_out


def setup_inputs(seed: int = 0) -> dict:
    key = jax.random.key(seed)
    ks = iter(jax.random.split(key, 64))
    f32 = jnp.float32

    def nrm(shape, std):
        return jax.random.normal(next(ks), shape, f32) * std

    def uni(shape, lo, hi):
        return jax.random.uniform(next(ks), shape, f32, lo, hi)

    D = D_MODEL
    NE, NO = N_EVEN, N_ODD
    W = RWKV_WIDTH
    G, P = S5_GROUPS, S5_STATE
    n_idx = jnp.arange(P, dtype=f32)
    return {
        'x': nrm((BATCH, SEQ, D), 1.0),
        'c': nrm((BATCH, D), 1.0),
        'ctx': nrm((BATCH, CTX_LEN, D), 1.0),
        'c_ctx': nrm((D,), 1.0),
        'norm_g': 1.0 + nrm((DEPTH, 3, D), 0.02),
        'ada_w': nrm((DEPTH, D, N_MOD * D), 0.5 * D ** -0.5),
        'ada_b': nrm((DEPTH, N_MOD * D), 0.02),
        'ffn_wg': nrm((DEPTH, 2, D, D_FF), D ** -0.5),
        'ffn_wu': nrm((DEPTH, 2, D, D_FF), D ** -0.5),
        'ffn_wd': nrm((DEPTH, 2, D_FF, D), D_FF ** -0.5),
        'final_g': 1.0 + nrm((D,), 0.02),
        'ev_w_in': nrm((NE, D, EVEN_IN), D ** -0.5),
        'ev_mu': uni((NE, RWKV_COLS), 0.0, 1.0),
        'ev_w0': uni((NE, 2, W), -6.5, -1.5),
        'ev_w_up': nrm((NE, 2, DECAY_LORA, W), 0.1 * DECAY_LORA ** -0.5),
        'ev_a0': nrm((NE, 2, W), 0.1),
        'ev_a_up': nrm((NE, 2, ICLR_LORA, W), ICLR_LORA ** -0.5),
        'ev_g_up': nrm((NE, GATE_LORA, W), GATE_LORA ** -0.5),
        'ev_k_k': 0.85 + nrm((NE, W), 0.02),
        'ev_k_a': 1.0 + nrm((NE, W), 0.02),
        'ev_r_k': -0.04 + nrm((NE, RWKV_HEADS, RWKV_HEAD_DIM), 0.02),
        'ev_gn_g': 1.0 + nrm((NE, W), 0.02),
        'ev_gn_b': nrm((NE, W), 0.02),
        'ev_lam_re': -0.5 + nrm((NE, 2, G, P), 0.01),
        'ev_lam_im': math.pi * n_idx + nrm((NE, 2, G, P), 0.01),
        'ev_log_dt': uni((NE, 2, G), math.log(DT_MIN), math.log(DT_MAX)),
        'ev_b_re': nrm((NE, 2, G, P, S5_GROUP), (2 * S5_GROUP) ** -0.5),
        'ev_b_im': nrm((NE, 2, G, P, S5_GROUP), (2 * S5_GROUP) ** -0.5),
        'ev_c_re': nrm((NE, 2, G, S5_GROUP, P), P ** -0.5),
        'ev_c_im': nrm((NE, 2, G, S5_GROUP, P), P ** -0.5),
        'ev_d': nrm((NE, S5_WIDTH), 1.0),
        'ev_w_glu': nrm((NE, S5_WIDTH, S5_WIDTH), S5_WIDTH ** -0.5),
        'ev_b_glu': nrm((NE, S5_WIDTH), 0.02),
        'ev_w_out': nrm((NE, EVEN_OUT, D), EVEN_OUT ** -0.5),
        'od_w_in': nrm((NO, D, HY_IN), D ** -0.5),
        'od_conv_w': nrm((NO, HY_SHORT, HY_IN), HY_SHORT ** -0.5),
        'od_conv_b': nrm((NO, HY_IN), 0.02),
        'od_fw1': nrm((NO, HY_EMB, HY_HIDDEN), HY_EMB ** -0.5),
        'od_fb1': nrm((NO, HY_HIDDEN), 0.02),
        'od_fw2': nrm((NO, HY_HIDDEN, HY_HIDDEN), HY_HIDDEN ** -0.5),
        'od_fb2': nrm((NO, HY_HIDDEN), 0.02),
        'od_fw3': nrm((NO, HY_HIDDEN, HY_HIDDEN), HY_HIDDEN ** -0.5),
        'od_fb3': nrm((NO, HY_HIDDEN), 0.02),
        'od_fw4': nrm((NO, HY_HIDDEN, HY_ORDER * 2 * HY_WIDTH), HY_HIDDEN ** -0.5),
        'od_freq': 1.0 + nrm((NO, HY_HIDDEN), 0.02),
        'od_bias': nrm((NO, HY_ORDER, HY_WIDTH), 0.5),
        'od_w_out': nrm((NO, HY_WIDTH, D), HY_WIDTH ** -0.5),
    }


def reference(x, c, ctx, c_ctx, norm_g, ada_w, ada_b, ffn_wg, ffn_wu, ffn_wd, final_g,
              ev_w_in, ev_mu, ev_w0, ev_w_up, ev_a0, ev_a_up, ev_g_up, ev_k_k, ev_k_a, ev_r_k,
              ev_gn_g, ev_gn_b, ev_lam_re, ev_lam_im, ev_log_dt, ev_b_re, ev_b_im, ev_c_re, ev_c_im,
              ev_d, ev_w_glu, ev_b_glu, ev_w_out,
              od_w_in, od_conv_w, od_conv_b, od_fw1, od_fb1, od_fw2, od_fb2, od_fw3, od_fb3, od_fw4,
              od_freq, od_bias, od_w_out):
    lat, cx = x, ctx
    last_ctx = 2 * (N_EVEN - 1)
    for l in range(DEPTH):
        run_ctx = l <= last_ctx
        ctx_out = l < last_ctx
        i = l // 2
        m_l = ada_mods(c, ada_w[l], ada_b[l])
        m_c = ada_mods(c_ctx, ada_w[l], ada_b[l]) if run_ctx else None
        lat = ffn_half(lat, norm_g[l, 0], m_l[0], m_l[1], m_l[2], ffn_wg[l, 0], ffn_wu[l, 0], ffn_wd[l, 0])
        if run_ctx:
            cx = ffn_half(cx, norm_g[l, 0], m_c[0], m_c[1], m_c[2], ffn_wg[l, 0], ffn_wu[l, 0], ffn_wd[l, 0])
        h_lat = modulate(lat, norm_g[l, 1], m_l[3], m_l[4])
        if l % 2 == 0:
            h_ctx = modulate(cx, norm_g[l, 1], m_c[3], m_c[4])
            prm = (ev_w_in[i], ev_mu[i], ev_w0[i], ev_w_up[i], ev_a0[i], ev_a_up[i], ev_g_up[i],
                   ev_k_k[i], ev_k_a[i], ev_r_k[i], ev_gn_g[i], ev_gn_b[i],
                   ev_lam_re[i], ev_lam_im[i], ev_log_dt[i], ev_b_re[i], ev_b_im[i], ev_c_re[i], ev_c_im[i],
                   ev_d[i], ev_w_glu[i], ev_b_glu[i], ev_w_out[i])
            y_lat, y_ctx = even_mixer(h_lat, h_ctx, ctx_out, prm)
        else:
            prm = (od_w_in[i], od_conv_w[i], od_conv_b[i], od_fw1[i], od_fb1[i], od_fw2[i], od_fb2[i],
                   od_fw3[i], od_fb3[i], od_fw4[i], od_freq[i], od_bias[i], od_w_out[i])
            y_lat = hyena_mixer(h_lat, prm)
            y_ctx = hyena_mixer(modulate(cx, norm_g[l, 1], m_c[3], m_c[4]), prm) if ctx_out else None
        lat = lat + m_l[5] * y_lat
        lat = ffn_half(lat, norm_g[l, 2], m_l[6], m_l[7], m_l[8], ffn_wg[l, 1], ffn_wu[l, 1], ffn_wd[l, 1])
        if ctx_out:
            cx = cx + m_c[5] * y_ctx
            cx = ffn_half(cx, norm_g[l, 2], m_c[6], m_c[7], m_c[8], ffn_wg[l, 1], ffn_wu[l, 1], ffn_wd[l, 1])
    return rms_norm(lat, final_g)
```

```cpp
#include <hip/hip_runtime.h>
#include <hip/hip_cooperative_groups.h>
#include <cstdio>
#include <cstdint>
#include <cstring>
namespace cg = cooperative_groups;
__device__ __forceinline__ int tidx() { int t = threadIdx.x; asm volatile("" : "+v"(t)); return t; }
__device__ __forceinline__ int bidx() { int t = blockIdx.x; asm volatile("" : "+s"(t)); return t; }
#define LAS __attribute__((address_space(3)))
#ifndef PG8_WGM
#define PG8_WGM 8
#endif
namespace pg8 {
#define PG8_LAS __attribute__((address_space(3)))
typedef unsigned short bf16_t;
typedef short bf16x8 __attribute__((ext_vector_type(8)));
typedef float f32x4 __attribute__((ext_vector_type(4)));
typedef unsigned u32x4 __attribute__((ext_vector_type(4)));
constexpr int BM = 256, BK = 64, HALF = 128, HTB = HALF * BK * 2  , STAGE_BYTES = 8 * HTB, NXCD = 8, WGM = PG8_WGM;

__host__ __device__ __forceinline__ int lds_byte(int r, int c) { const int st = (r >> 4) * 2 + (c >> 5), rr = r & 15, cc = c & 31, ob = rr * 64 + cc * 2; return st * 1024 + (ob ^ (((ob >> 9) & 1) << 5)); }
__host__ __device__ __forceinline__ void stage_rc(int b, int& R, int& C) { const int st = b / 1024, sb = b % 1024, swz = sb ^ (((sb >> 9) & 1) << 5); R = (st >> 1) * 16 + swz / 64; C = (st & 1) * 32 + (swz % 64) / 2; }
__host__ __device__ __forceinline__ int perm32(int rho) { const int n = rho >> 4, i = rho & 15; return 8 * (i >> 2) + 4 * n + (i & 3); }

struct Unit { int pm, pn; };
struct Gemm { const bf16_t* A; const bf16_t* Bt; int M, N, K; int Kloop; };

struct StaticOrder {
    int nM, nN, nwg, G, c, wgm = WGM;
    __host__ __device__ void init(int M, int N, int G_, int c_) { nM = M / BM; nN = N / BM; nwg = nM * nN; G = G_; c = c_; }
    __host__ __device__ bool next(int i, Unit& u) const {
        const long L = (long)i * G + c; if (L >= nwg) return false;
        int wgid = (int)L; { const int q = nwg / NXCD, r = nwg % NXCD, xcd = wgid % NXCD, off = wgid / NXCD; wgid = (xcd < r ? xcd * (q + 1) : r * (q + 1) + (xcd - r) * q) + off; }
        const int nig = wgm * nN, gid = wgid / nig, fm = gid * wgm, gsz = (nM - fm) < wgm ? (nM - fm) : wgm;
        u.pm = fm + ((wgid % nig) % gsz); u.pn = (wgid % nig) / gsz; return true;
    }
    __device__ __forceinline__ void a_ready(const Unit&) const {}
    __device__ __forceinline__ void done(const Unit&) const {}
};

__device__ __forceinline__ unsigned cvt_pk_bf16(float lo, float hi) { unsigned r; asm volatile("v_cvt_pk_bf16_f32 %0, %1, %2" : "=v"(r) : "v"(lo), "v"(hi)); return r; }
typedef float f32x2 __attribute__((ext_vector_type(2)));
__device__ __forceinline__ f32x2 gelu_pk(f32x2 v) {
    const f32x2 av = __builtin_elementwise_abs(v), d = av * 0.2316418882f + 1.0f;
    f32x2 t; t.x = __builtin_amdgcn_rcpf(d.x); t.y = __builtin_amdgcn_rcpf(d.y);
    f32x2 q = t * 0.5307027145f + (-0.7265760135f); q = q * t + 0.7107068705f; q = q * t + (-0.142248368f); q = q * t + 0.127414796f; q = q * t;
    const f32x2 s = (v * v) * (-0.72134752044f);
    f32x2 e; e.x = __builtin_amdgcn_exp2f(s.x); e.y = __builtin_amdgcn_exp2f(s.y);
    const f32x2 m = v * (q * e), r = v - m;
    f32x2 o; o.x = v.x < 0.f ? m.x : r.x; o.y = v.y < 0.f ? m.y : r.y; return o;
}

template <class Epi, class Sched, bool ALIGN_EPI = false, bool SP2 = false>
__device__ __forceinline__ void gemm_phase(PG8_LAS unsigned char* lds, const Gemm g, const Sched& S, const Epi& E) {
    const int tid = tidx(), wid = __builtin_amdgcn_readfirstlane(tid >> 6), lane = tid & 63, wr = wid >> 2, wc = wid & 3, fr = lane & 15, fq = lane >> 4;
    const int K = g.K, nt = g.Kloop / BK;
    unsigned voffA[2], voffB[2];
#pragma unroll
    for (int i = 0; i < 2; ++i) { int R, C; stage_rc(tid * 16 + i * 8192, R, C); const int Rb = Epi::PERM ? ((R & ~31) + perm32(R & 31)) : R;
        voffA[i] = (unsigned)(R * K + C) * 2u; voffB[i] = (unsigned)(Rb * K + C) * 2u; }
    const size_t kstep = (size_t)(BK * 2);
    const size_t hstep = (size_t)HALF * K * 2;
    const size_t tstep = 2 * hstep;
    const unsigned ldsw = (unsigned)wid * 1024u;
    const int aoff = lds_byte(wr * 64 + fr, fq * 8), boff = lds_byte(wc * 32 + fr, fq * 8);
#define PG8_SA(b, h) (((b) * 2 + (h)) * HTB)
#define PG8_SB(b, h) ((4 + (b) * 2 + (h)) * HTB)
#define PG8_STAGE(bufoff, gbase, voff) do { _Pragma("unroll") for (int _i = 0; _i < 2; ++_i) \
        __builtin_amdgcn_global_load_lds((const unsigned*)((const char*)(gbase) + (voff)[_i]), (PG8_LAS unsigned*)(lds + (bufoff) + ldsw + _i * 8192), 16, 0, 0); } while (0)
#define PG8_LDA(dst, b, h) do { _Pragma("unroll") for (int m = 0; m < 4; ++m) _Pragma("unroll") for (int k = 0; k < 2; ++k) dst[m][k] = *(const PG8_LAS bf16x8*)(lds + PG8_SA(b, h) + aoff + m * 2048 + k * 1024); } while (0)
#define PG8_LDB(dst, b, h) do { _Pragma("unroll") for (int n = 0; n < 2; ++n) _Pragma("unroll") for (int k = 0; k < 2; ++k) dst[n][k] = *(const PG8_LAS bf16x8*)(lds + PG8_SB(b, h) + boff + n * 2048 + k * 1024); } while (0)
#define PG8_MMA(ai, bj, At, Bt) do { __builtin_amdgcn_s_setprio(1); _Pragma("unroll") for (int m = 0; m < 4; ++m) _Pragma("unroll") for (int n = 0; n < 2; ++n) _Pragma("unroll") for (int k = 0; k < 2; ++k) \
        acc[ai][bj][m][n] = __builtin_amdgcn_mfma_f32_16x16x32_bf16(Bt[n][k], At[m][k], acc[ai][bj][m][n], 0, 0, 0); __builtin_amdgcn_s_setprio(0); } while (0)
#define PG8_WAIT_V(n) asm volatile("s_waitcnt vmcnt(" #n ")" ::: "memory")
#define PG8_WAIT_L(n) asm volatile("s_waitcnt lgkmcnt(" #n ")" ::: "memory")
#define PG8_BAR __builtin_amdgcn_s_barrier()
#define PG8_SCHED __builtin_amdgcn_sched_barrier(0)
    Unit cur, nxt; int ui = 0;
    if (!S.next(0, cur)) return;
    f32x4 acc[2][2][4][2];
#pragma unroll
    for (int a = 0; a < 2; ++a)
#pragma unroll
        for (int b = 0; b < 2; ++b)
#pragma unroll
            for (int m = 0; m < 4; ++m)
#pragma unroll
                for (int n = 0; n < 2; ++n) acc[a][b][m][n] = (f32x4){0.f, 0.f, 0.f, 0.f};
    bf16x8 At[4][2], B0[2][2], B1[2][2];
    const char* cA = (const char*)g.A + (size_t)cur.pm * tstep; const char* cB = (const char*)g.Bt + (size_t)cur.pn * tstep;
    S.a_ready(cur);
    if constexpr (SP2) {
        PG8_STAGE(PG8_SB(0, 0), cB, voffB); PG8_STAGE(PG8_SB(0, 1), cB + hstep, voffB); PG8_STAGE(PG8_SA(0, 0), cA, voffA); PG8_STAGE(PG8_SA(0, 1), cA + hstep, voffA);
        if (wr == 1) PG8_BAR;
        PG8_WAIT_V(2); PG8_BAR;
        PG8_STAGE(PG8_SB(1, 0), cB + kstep, voffB); PG8_STAGE(PG8_SA(1, 0), cA + kstep, voffA); PG8_STAGE(PG8_SB(1, 1), cB + hstep + kstep, voffB);
        PG8_WAIT_V(6); PG8_BAR;
    } else {
        PG8_STAGE(PG8_SB(0, 0), cB, voffB); PG8_STAGE(PG8_SA(0, 0), cA, voffA); PG8_STAGE(PG8_SB(0, 1), cB + hstep, voffB); PG8_STAGE(PG8_SA(0, 1), cA + hstep, voffA);
        if (wr == 1) PG8_BAR;
        PG8_WAIT_V(4); PG8_BAR;
        PG8_STAGE(PG8_SB(1, 0), cB + kstep, voffB); PG8_STAGE(PG8_SA(1, 0), cA + kstep, voffA); PG8_STAGE(PG8_SB(1, 1), cB + hstep + kstep, voffB);
        PG8_WAIT_V(6); PG8_BAR;
    }
    for (;;) {
        const bool has_next = S.next(ui + 1, nxt);
        const char* nA = has_next ? (const char*)g.A + (size_t)nxt.pm * tstep : cA; const char* nB = has_next ? (const char*)g.Bt + (size_t)nxt.pn * tstep : cB;
        for (int t = 0; t < nt; t += 2) {
            const bool last = (t == nt - 2);
            const char* a1 = cA + (size_t)(t + 1) * kstep;
            const char* a2 = last ? nA : cA + (size_t)(t + 2) * kstep; const char* b2 = last ? nB : cB + (size_t)(t + 2) * kstep;
            const char* a3 = a2 + kstep; const char* b3 = b2 + kstep;
            if (last && has_next) S.a_ready(nxt);
            if constexpr (SP2) {
            PG8_LDB(B0, 0, 0); PG8_LDB(B1, 0, 1); PG8_SCHED; PG8_LDA(At, 0, 0); PG8_STAGE(PG8_SA(1, 1), a1 + hstep, voffA);
            PG8_WAIT_V(8); PG8_WAIT_L(0); PG8_BAR; PG8_MMA(0, 0, At, B0); PG8_MMA(0, 1, At, B1); PG8_BAR; PG8_SCHED;
            PG8_LDA(At, 0, 1); PG8_STAGE(PG8_SB(0, 0), b2, voffB); PG8_STAGE(PG8_SB(0, 1), b2 + hstep, voffB); PG8_STAGE(PG8_SA(0, 0), a2, voffA);
            PG8_WAIT_V(8); PG8_WAIT_L(0); PG8_BAR; PG8_MMA(1, 0, At, B0); PG8_MMA(1, 1, At, B1); PG8_BAR; PG8_SCHED;
            PG8_LDB(B0, 1, 0); PG8_LDB(B1, 1, 1); PG8_SCHED; PG8_LDA(At, 1, 0); PG8_STAGE(PG8_SA(0, 1), a2 + hstep, voffA);
            PG8_WAIT_V(8); PG8_WAIT_L(0); PG8_BAR; PG8_MMA(0, 0, At, B0); PG8_MMA(0, 1, At, B1); PG8_BAR; PG8_SCHED;
            PG8_LDA(At, 1, 1); PG8_STAGE(PG8_SB(1, 0), b3, voffB); PG8_STAGE(PG8_SB(1, 1), b3 + hstep, voffB); PG8_STAGE(PG8_SA(1, 0), a3, voffA);
            PG8_WAIT_V(8); PG8_WAIT_L(0); PG8_BAR; PG8_MMA(1, 0, At, B0); PG8_MMA(1, 1, At, B1); PG8_BAR; PG8_SCHED;
            } else {
            PG8_LDB(B0, 0, 0); PG8_SCHED; PG8_LDA(At, 0, 0); PG8_STAGE(PG8_SA(1, 1), a1 + hstep, voffA);
            PG8_WAIT_L(8); PG8_BAR; PG8_WAIT_L(0); PG8_MMA(0, 0, At, B0); PG8_BAR; PG8_SCHED;
            PG8_LDB(B1, 0, 1); PG8_STAGE(PG8_SB(0, 0), b2, voffB);
            PG8_BAR; PG8_WAIT_L(0); PG8_MMA(0, 1, At, B1); PG8_BAR;
            PG8_LDA(At, 0, 1); PG8_STAGE(PG8_SA(0, 0), a2, voffA);
            PG8_BAR; PG8_WAIT_L(0); PG8_MMA(1, 0, At, B0); PG8_BAR; PG8_SCHED;
            PG8_STAGE(PG8_SB(0, 1), b2 + hstep, voffB);
            PG8_WAIT_V(6); PG8_BAR; PG8_MMA(1, 1, At, B1); PG8_BAR;
            PG8_LDB(B0, 1, 0); PG8_SCHED; PG8_LDA(At, 1, 0); PG8_STAGE(PG8_SA(0, 1), a2 + hstep, voffA);
            PG8_WAIT_L(8); PG8_BAR; PG8_WAIT_L(0); PG8_MMA(0, 0, At, B0); PG8_BAR; PG8_SCHED;
            PG8_LDB(B1, 1, 1); PG8_STAGE(PG8_SB(1, 0), b3, voffB);
            PG8_BAR; PG8_WAIT_L(0); PG8_MMA(0, 1, At, B1); PG8_BAR;
            PG8_LDA(At, 1, 1); PG8_STAGE(PG8_SA(1, 0), a3, voffA);
            PG8_BAR; PG8_WAIT_L(0); PG8_MMA(1, 0, At, B0); PG8_BAR; PG8_SCHED;
            PG8_STAGE(PG8_SB(1, 1), b3 + hstep, voffB);
            PG8_WAIT_V(6); PG8_BAR; PG8_MMA(1, 1, At, B1); PG8_BAR;
            }
        }
        if constexpr (ALIGN_EPI) { if (wr == 0) PG8_BAR; }
        if constexpr (!Epi::AFTER_DRAIN) { E(acc, cur, wr, wc, fr, fq); S.done(cur); }
        if (!has_next) break;
#pragma unroll
        for (int a = 0; a < 2; ++a)
#pragma unroll
            for (int b = 0; b < 2; ++b)
#pragma unroll
                for (int m = 0; m < 4; ++m)
#pragma unroll
                    for (int n = 0; n < 2; ++n) acc[a][b][m][n] = (f32x4){0.f, 0.f, 0.f, 0.f};
        cur = nxt; cA = nA; cB = nB; ++ui;
        if constexpr (ALIGN_EPI) { if (wr == 1) PG8_BAR; }
    }
    PG8_WAIT_V(0);
    if constexpr (!ALIGN_EPI) { if (wr == 0) PG8_BAR; }
    PG8_BAR;
    if constexpr (Epi::AFTER_DRAIN) { E.fused(acc, cur, wr, wc, fr, fq, lds, wid, lane); S.done(cur); }
#undef PG8_SA
#undef PG8_SB
#undef PG8_STAGE
#undef PG8_LDA
#undef PG8_LDB
#undef PG8_MMA
#undef PG8_WAIT_V
#undef PG8_WAIT_L
#undef PG8_BAR
#undef PG8_SCHED
}
}
#define XB_TMO      128
#define XB_XCNT(j)  (256  + 64 * (j))
#define XB_XSUB(j)  (1280 + 64 * (j))
#define XB_XGEN(j)  (2304 + 64 * (j))
#define XB_TOP      3328
#define XB_TOPGEN   3392
#define XCD_BAR_WORDS 3456
#define XB_SPIN_CAP (1u << 18)

__device__ __forceinline__ unsigned xb_ld(unsigned* p)              { return __hip_atomic_load(p, __ATOMIC_RELAXED, __HIP_MEMORY_SCOPE_AGENT); }
__device__ __forceinline__ unsigned xb_add(unsigned* p, unsigned v) { return __hip_atomic_fetch_add(p, v, __ATOMIC_RELAXED, __HIP_MEMORY_SCOPE_AGENT); }
__device__ __forceinline__ unsigned xb_xcc_id() { return (unsigned)__builtin_amdgcn_s_getreg((3 << 11) | 20) & 0xFu; }
#define XB_SPIN(cond, bar) do { unsigned _sp = 0; while (cond) { __builtin_amdgcn_s_sleep(1); \
    if ((++_sp & 255u) == 0u) { if (xb_ld(&(bar)[XB_TMO])) break; if (_sp > XB_SPIN_CAP) { atomicAdd(&(bar)[XB_TMO], 1u); break; } } } } while (0)

struct XcdBarrier {
    unsigned* bar; unsigned x;
    volatile LAS unsigned* st;
};

__device__ __forceinline__ XcdBarrier xcd_barrier_post(unsigned* bar, volatile LAS unsigned* st) {
    XcdBarrier b; b.bar = bar; b.x = xb_xcc_id(); b.st = st;
    if (threadIdx.x == 0) (void)xb_add(&bar[XB_XCNT(b.x)], 1u);
    return b;
}
__device__ __forceinline__ void xcd_barrier_complete(unsigned* bar, unsigned x, unsigned& nloc, unsigned& nx) {
    const unsigned G = gridDim.x * gridDim.y * gridDim.z;
    unsigned sum, cnt, mine, sp = 0u;
    for (;;) {
        sum = 0u; cnt = 0u; mine = 0u;
#pragma unroll
        for (unsigned j = 0; j < 16; ++j) { const unsigned c = xb_ld(&bar[XB_XCNT(j)]); sum += c; cnt += (c > 0u) ? 1u : 0u; mine = (j == x) ? c : mine; }
        if (sum == G) break;
        __builtin_amdgcn_s_sleep(1);
        if ((++sp & 255u) == 0u) { if (xb_ld(&bar[XB_TMO])) break; if (sp > XB_SPIN_CAP) { atomicAdd(&bar[XB_TMO], 1u); break; } }
    }
    nloc = mine > 0u ? mine : 1u; nx = cnt > 0u ? cnt : 1u;
}

__device__ __forceinline__ void xcd_barrier(const XcdBarrier& b) {
    asm volatile("s_waitcnt vmcnt(0)" ::: "memory");
    __syncthreads();
    if (threadIdx.x == 0) {
        unsigned* bar = b.bar;
        __builtin_amdgcn_s_waitcnt(0);
        unsigned nloc = b.st[0], nx = b.st[1];
        if (nloc == 0u) { xcd_barrier_complete(bar, b.x, nloc, nx); b.st[0] = nloc; b.st[1] = nx; }
        const unsigned old = xb_add(&bar[XB_XSUB(b.x)], 1u);
        const unsigned gen = old / nloc;
        if (old + 1u == (gen + 1u) * nloc) {
            __builtin_amdgcn_fence(__ATOMIC_RELEASE, "agent");
            asm volatile("s_waitcnt vmcnt(0)" ::: "memory");
            const unsigned og = xb_add(&bar[XB_TOP], 1u);
            const unsigned tg = og / nx;
            if (og + 1u == (tg + 1u) * nx) xb_add(&bar[XB_TOPGEN], 1u);
            else XB_SPIN(xb_ld(&bar[XB_TOPGEN]) == tg, bar);
            __builtin_amdgcn_fence(__ATOMIC_ACQUIRE, "agent");
            xb_add(&bar[XB_XGEN(b.x)], 1u);
            asm volatile("s_waitcnt vmcnt(0)" ::: "memory");
        } else {
            XB_SPIN(xb_ld(&bar[XB_XGEN(b.x)]) == gen, bar);
            __builtin_amdgcn_fence(__ATOMIC_ACQUIRE, "agent");
            asm volatile("s_waitcnt vmcnt(0)" ::: "memory");
        }
    }
    __syncthreads();
}


#ifndef WGM_DEFAULT
#define WGM_DEFAULT 4
#endif
#ifndef WGM_SWAPPED
#define WGM_SWAPPED 6
#endif
#ifndef GEMM_SP2
#define GEMM_SP2 true
#endif
#ifndef GEMM_ALIGN
#define GEMM_ALIGN true
#endif
using pg8::bf16_t; using pg8::bf16x8; using pg8::f32x4; using pg8::u32x4; using pg8::Unit; using pg8::cvt_pk_bf16;
#define LAS __attribute__((address_space(3)))
typedef unsigned u32x2 __attribute__((ext_vector_type(2)));

constexpr int D = 1024, NB = 4, SEQ = 8192, CTXL = 256, DFF = 2816;
constexpr int TLAT = NB * SEQ, TCTX = NB * CTXL, TT = TLAT + TCTX;
constexpr int NTHREADS = 512;
constexpr int LDS_BYTES = 152576;
constexpr size_t SE = (size_t)TT * 512;
constexpr size_t SB = SE * 2;

enum { I_X = 0, I_C, I_CTX, I_CCTX, I_NORMG, I_ADAW, I_ADAB, I_WG, I_WU, I_WD, I_FINALG,
       I_EWIN, I_EMU, I_EW0, I_EWUP, I_EA0, I_EAUP, I_EGUP, I_EKK, I_EKA, I_ERK, I_EGNG, I_EGNB,
       I_ELRE, I_ELIM, I_ELOGDT, I_EBRE, I_EBIM, I_ECRE, I_ECIM, I_ED, I_EWGLU, I_EBGLU, I_EWOUT,
       I_OWIN, I_OCW, I_OCB, I_OFW1, I_OFB1, I_OFW2, I_OFB2, I_OFW3, I_OFB3, I_OFW4, I_OFREQ, I_OBIAS, I_OWOUT, N_IN };

constexpr size_t OFF_MODS = 16384;
constexpr size_t MODS_BYTES = (size_t)4 * 5 * 9216 * 4;
constexpr size_t OFF_MPART = OFF_MODS + MODS_BYTES;
constexpr size_t OFF_XC = OFF_MPART + 8 * MODS_BYTES;
constexpr size_t OFF_HDN = OFF_XC + (size_t)TCTX * D * 4;
constexpr size_t OFF_HDNC = OFF_HDN + (size_t)2 * 8192 * 64 * 4;
constexpr size_t OFF_HDNB = OFF_HDNC + (size_t)256 * 64 * 4;
constexpr size_t OFF_W1 = OFF_HDNB + (size_t)2 * 8192 * 64 * 2;
constexpr size_t W1_BYTES = (size_t)5632 * 1024 * 2;
constexpr size_t OFF_W2 = OFF_W1 + 2 * W1_BYTES;
constexpr size_t W2_BYTES = (size_t)1024 * 2816 * 2;
constexpr size_t OFF_WMIX = OFF_W2 + 2 * W2_BYTES;
constexpr size_t WMIX_BYTES = 10485760;
constexpr size_t WM_EWIN = 0, WM_ELORA = 5242880, WM_EGLU = WM_ELORA + 1966080, WM_EOUT = WM_EGLU + 524288;
constexpr size_t WM_OWIN = 0, WM_OOUT = 6291456;
constexpr size_t OFF_H = OFF_WMIX + WMIX_BYTES;
constexpr size_t OFF_BIG = OFF_H + (size_t)TT * D * 2;
constexpr size_t B_U = 0, B_PR = SB, B_RVK = 5 * SB, B_G = 9 * SB, B_LORA = 10 * SB, B_O = 10 * SB, B_YS = 12 * SB;
constexpr size_t B_PT = 0, B_ZT = 6 * SB, B_KS = 8 * SB;
constexpr size_t WS_END = OFF_BIG + 14 * SB;
static_assert(WS_END <= 636508160ull, "workspace too large");
static_assert(B_KS + (size_t)256 * (2 * 16384 + 8192) * 8 <= 14 * SB, "hyena scratch");

enum { PH_PREP_A = 0, PH_PREP_B, PH_CONV_NORM, PH_NORM, PH_F1, PH_F2, PH_E1, PH_FEAT, PH_E3, PH_SCAN, PH_READ, PH_GLU, PH_EOUT,
       PH_O1, PH_HY, PH_TR, PH_OOUT, PH_FINAL };
struct Phase { int type, l, a, b; };
struct Params { const float* in[N_IN]; float* out; char* ws; int nph; int pad; Phase ph[128]; };
typedef const __attribute__((address_space(4))) Params* PP;

__device__ __forceinline__ float bf2f(unsigned short v) { return __uint_as_float(((unsigned)v) << 16); }
__device__ __forceinline__ unsigned short f2bf(float f) { unsigned u = __float_as_uint(f); u += 0x7FFFu + ((u >> 16) & 1u); return (unsigned short)(u >> 16); }
__device__ __forceinline__ unsigned pk2(float a, float b) { return (unsigned)f2bf(a) | ((unsigned)f2bf(b) << 16); }
__device__ __forceinline__ float lo16(unsigned w) { return __uint_as_float(w << 16); }
__device__ __forceinline__ float hi16(unsigned w) { return __uint_as_float(w & 0xffff0000u); }
__device__ __forceinline__ float wave_sum(float v) {
#pragma unroll
    for (int o = 1; o < 64; o <<= 1) v += __shfl_xor(v, o);
    return v;
}
__device__ __forceinline__ float sigm(float x) { return __builtin_amdgcn_rcpf(1.f + __expf(-x)); }
template <int CTRL> __device__ __forceinline__ float dpp_mov(float x) { return __int_as_float(__builtin_amdgcn_update_dpp(0, __float_as_int(x), CTRL, 0xF, 0xF, true)); }
__device__ __forceinline__ float red16(float x) { x += dpp_mov<0xB1>(x); x += dpp_mov<0x4E>(x); x += dpp_mov<0x124>(x); x += dpp_mov<0x128>(x); return x; }
__device__ __forceinline__ void red16x2(float& a, float& b) { a += dpp_mov<0xB1>(a); b += dpp_mov<0xB1>(b); a += dpp_mov<0x4E>(a); b += dpp_mov<0x4E>(b); a += dpp_mov<0x124>(a); b += dpp_mov<0x124>(b); a += dpp_mov<0x128>(a); b += dpp_mov<0x128>(b); }
#define LDS_FENCE() asm volatile("s_waitcnt lgkmcnt(0)" ::: "memory")

struct EpiSwiglu {
    static constexpr bool PERM = true, AFTER_DRAIN = false;
    bf16_t* O;
    __device__ __forceinline__ void operator()(const f32x4 (&acc)[2][2][4][2], const Unit& u, int wr, int wc, int fr, int fq) const {
        const int row0 = u.pm * 256 + wr * 64 + fr, col0 = u.pn * 128 + wc * 32 + 8 * fq;
#pragma unroll
        for (int ai = 0; ai < 2; ++ai)
#pragma unroll
            for (int m = 0; m < 4; ++m) { bf16_t* rowp = O + (size_t)(row0 + ai * 128 + m * 16) * DFF + col0;
                const f32x4 g0 = acc[ai][0][m][0], g1 = acc[ai][0][m][1], u0 = acc[ai][1][m][0], u1 = acc[ai][1][m][1];
                u32x4 w;
                w.x = cvt_pk_bf16(g0[0] * sigm(g0[0]) * u0[0], g0[1] * sigm(g0[1]) * u0[1]); w.y = cvt_pk_bf16(g0[2] * sigm(g0[2]) * u0[2], g0[3] * sigm(g0[3]) * u0[3]);
                w.z = cvt_pk_bf16(g1[0] * sigm(g1[0]) * u1[0], g1[1] * sigm(g1[1]) * u1[1]); w.w = cvt_pk_bf16(g1[2] * sigm(g1[2]) * u1[2], g1[3] * sigm(g1[3]) * u1[3]);
                *(u32x4*)rowp = w; }
    }
};
struct EpiBf16Out {
    static constexpr bool PERM = true, AFTER_DRAIN = false;
    bf16_t* O0; int ld0; int nt0; bf16_t* O1; int ld1;
    __device__ __forceinline__ void operator()(const f32x4 (&acc)[2][2][4][2], const Unit& u, int wr, int wc, int fr, int fq) const {
        const int row0 = u.pm * 256 + wr * 64 + fr;
        bf16_t* base; int ld, colt;
        if (u.pn < nt0) { base = O0; ld = ld0; colt = u.pn * 256; } else { base = O1; ld = ld1; colt = (u.pn - nt0) * 256; }
        const int col0 = colt + wc * 32 + 8 * fq;
#pragma unroll
        for (int ai = 0; ai < 2; ++ai)
#pragma unroll
            for (int m = 0; m < 4; ++m) { bf16_t* rowp = base + (size_t)(row0 + ai * 128 + m * 16) * ld + col0;
#pragma unroll
                for (int bj = 0; bj < 2; ++bj) { const f32x4 v0 = acc[ai][bj][m][0], v1 = acc[ai][bj][m][1];
                    u32x4 w; w.x = cvt_pk_bf16(v0[0], v0[1]); w.y = cvt_pk_bf16(v0[2], v0[3]); w.z = cvt_pk_bf16(v1[0], v1[1]); w.w = cvt_pk_bf16(v1[2], v1[3]);
                    *(u32x4*)(rowp + bj * 128) = w; } }
    }
};
struct EpiLora {
    static constexpr bool PERM = true, AFTER_DRAIN = false;
    bf16_t* EA; bf16_t* G; const float* w0; const float* a0; int pn_off;
    __device__ __forceinline__ void operator()(const f32x4 (&acc)[2][2][4][2], const Unit& u, int wr, int wc, int fr, int fq) const {
        const int row0 = u.pm * 256 + wr * 64 + fr; const int type = (u.pn + pn_off) >> 1; const int col0 = (u.pn & 1) * 256 + wc * 32 + 8 * fq;
        bf16_t* base = (type < 4 ? EA + (size_t)type * SE : G) + (size_t)row0 * 512 + col0;
        const float* bias = (type < 2 ? w0 + type * 512 : a0 + (type & 1) * 512) + col0;
        const float mul = type < 2 ? 0.60653065971f : 1.0f;
        if (type < 4) {
#pragma unroll
            for (int bj = 0; bj < 2; ++bj) {
                const f32x4 b0 = *(const f32x4*)(bias + bj * 128), b1 = *(const f32x4*)(bias + bj * 128 + 4);
#pragma unroll
                for (int ai = 0; ai < 2; ++ai)
#pragma unroll
                    for (int m = 0; m < 4; ++m) { f32x4 v0 = acc[ai][bj][m][0] + b0, v1 = acc[ai][bj][m][1] + b1;
#pragma unroll
                        for (int j = 0; j < 4; ++j) { v0[j] = mul * sigm(v0[j]); v1[j] = mul * sigm(v1[j]); }
                        u32x4 w; w.x = cvt_pk_bf16(v0[0], v0[1]); w.y = cvt_pk_bf16(v0[2], v0[3]); w.z = cvt_pk_bf16(v1[0], v1[1]); w.w = cvt_pk_bf16(v1[2], v1[3]);
                        *(u32x4*)(base + (size_t)(ai * 128 + m * 16) * 512 + bj * 128) = w; } }
        } else {
#pragma unroll
            for (int bj = 0; bj < 2; ++bj)
#pragma unroll
                for (int ai = 0; ai < 2; ++ai)
#pragma unroll
                    for (int m = 0; m < 4; ++m) { const f32x4 v0 = acc[ai][bj][m][0], v1 = acc[ai][bj][m][1];
                        u32x4 w; w.x = cvt_pk_bf16(v0[0], v0[1]); w.y = cvt_pk_bf16(v0[2], v0[3]); w.z = cvt_pk_bf16(v1[0], v1[1]); w.w = cvt_pk_bf16(v1[2], v1[3]);
                        *(u32x4*)(base + (size_t)(ai * 128 + m * 16) * 512 + bj * 128) = w; }
        }
    }
};
struct EpiGlu {
    static constexpr bool PERM = true, AFTER_DRAIN = false;
    const bf16_t* YG; bf16_t* YCAT; const float* bglu;
    __device__ __forceinline__ void operator()(const f32x4 (&acc)[2][2][4][2], const Unit& u, int wr, int wc, int fr, int fq) const {
        const int row0 = u.pm * 256 + wr * 64 + fr; const int col0 = u.pn * 256 + wc * 32 + 8 * fq;
        f32x4 bv[2][2];
#pragma unroll
        for (int bj = 0; bj < 2; ++bj)
#pragma unroll
            for (int n = 0; n < 2; ++n) bv[bj][n] = *(const f32x4*)(bglu + col0 + bj * 128 + 4 * n);
#pragma unroll
        for (int ai = 0; ai < 2; ++ai)
#pragma unroll
            for (int m = 0; m < 4; ++m) { const size_t row = (size_t)(row0 + ai * 128 + m * 16);
#pragma unroll
                for (int bj = 0; bj < 2; ++bj) { f32x4 v0 = acc[ai][bj][m][0] + bv[bj][0], v1 = acc[ai][bj][m][1] + bv[bj][1];
                    const u32x4 y = *(const u32x4*)(YG + row * 512 + col0 + bj * 128);
                    v0[0] = lo16(y.x) * sigm(v0[0]); v0[1] = hi16(y.x) * sigm(v0[1]); v0[2] = lo16(y.y) * sigm(v0[2]); v0[3] = hi16(y.y) * sigm(v0[3]);
                    v1[0] = lo16(y.z) * sigm(v1[0]); v1[1] = hi16(y.z) * sigm(v1[1]); v1[2] = lo16(y.w) * sigm(v1[2]); v1[3] = hi16(y.w) * sigm(v1[3]);
                    u32x4 w; w.x = cvt_pk_bf16(v0[0], v0[1]); w.y = cvt_pk_bf16(v0[2], v0[3]); w.z = cvt_pk_bf16(v1[0], v1[1]); w.w = cvt_pk_bf16(v1[2], v1[3]);
                    *(u32x4*)(YCAT + row * 1024 + 512 + col0 + bj * 128) = w; } }
    }
};
struct EpiResid {
    static constexpr bool PERM = false, AFTER_DRAIN = false;
    const float* in_lat; const float* in_ctx; float* out_lat; float* out_ctx; const float* gate; float scale;
    __device__ __forceinline__ void operator()(const f32x4 (&acc)[2][2][4][2], const Unit& u, int wr, int wc, int fr, int fq) const {
        const bool isctx = u.pm >= 128; const int ci = isctx ? 4 : (u.pm >> 5);
        const int row0 = (isctx ? (u.pm - 128) * 256 : u.pm * 256) + wr * 64 + fr, col0 = u.pn * 256 + wc * 32 + 4 * fq;
        const float* src = isctx ? in_ctx : in_lat; float* dst = isctx ? out_ctx : out_lat; const float* gp = gate + (size_t)ci * 9216;
        f32x4 gv[2][2];
#pragma unroll
        for (int bj = 0; bj < 2; ++bj)
#pragma unroll
            for (int n = 0; n < 2; ++n) gv[bj][n] = *(const f32x4*)(gp + col0 + bj * 128 + n * 16) * scale;
#pragma unroll
        for (int ai = 0; ai < 2; ++ai)
#pragma unroll
            for (int m = 0; m < 4; ++m) { const size_t ro = (size_t)(row0 + ai * 128 + m * 16) * D + col0;
#pragma unroll
                for (int bj = 0; bj < 2; ++bj)
#pragma unroll
                    for (int n = 0; n < 2; ++n) { const f32x4 x = *(const f32x4*)(src + ro + bj * 128 + n * 16);
                        *(f32x4*)(dst + ro + bj * 128 + n * 16) = x + gv[bj][n] * acc[ai][bj][m][n]; } }
    }
};
struct EpiPartial {
    static constexpr bool PERM = false, AFTER_DRAIN = false;
    float* out; const float* gate; float scale;
    __device__ __forceinline__ void operator()(const f32x4 (&acc)[2][2][4][2], const Unit& u, int wr, int wc, int fr, int fq) const {
        const int row0 = u.pm * 256 + wr * 64 + fr, col0 = u.pn * 256 + wc * 32 + 4 * fq;
        f32x4 gv[2][2];
#pragma unroll
        for (int bj = 0; bj < 2; ++bj)
#pragma unroll
            for (int n = 0; n < 2; ++n) gv[bj][n] = *(const f32x4*)(gate + col0 + bj * 128 + n * 16) * scale;
#pragma unroll
        for (int ai = 0; ai < 2; ++ai)
#pragma unroll
            for (int m = 0; m < 4; ++m) { float* rp = out + (size_t)(row0 + ai * 128 + m * 16) * D + col0;
#pragma unroll
                for (int bj = 0; bj < 2; ++bj)
#pragma unroll
                    for (int n = 0; n < 2; ++n) *(f32x4*)(rp + bj * 128 + n * 16) = gv[bj][n] * acc[ai][bj][m][n]; }
    }
};
struct OneUnit { Unit u; int has;
    __device__ __forceinline__ bool next(int i, Unit& o) const { if (i == 0 && has) { o = u; return true; } return false; }
    __device__ __forceinline__ void a_ready(const Unit&) const {}
    __device__ __forceinline__ void done(const Unit&) const {} };
__device__ __forceinline__ void ctx_splitk(LAS unsigned char* lds, const bf16_t* Actx, const bf16_t* Bt, int K, float* PART, const float* gate, float scale) {
    const int nk = K / 256, nsub = 16 * nk; int blk = bidx();
    OneUnit S; S.has = blk < nsub ? 1 : 0; const int unit = S.has ? blk / nk : 0, kc = S.has ? blk % nk : 0; S.u.pm = unit >> 2; S.u.pn = unit & 3;
    int Kl = 256, Ks = K; asm volatile("" : "+s"(Kl), "+s"(Ks));
    pg8::Gemm g; g.A = Actx + kc * 256; g.Bt = Bt + kc * 256; g.M = 1024; g.N = 1024; g.K = Ks; g.Kloop = Kl;
    EpiPartial E; E.out = PART + (size_t)kc * TCTX * D; E.gate = gate; E.scale = scale;
    pg8::gemm_phase<EpiPartial, OneUnit, false, GEMM_SP2>(lds, g, S, E);
}
template <class Epi> __device__ __forceinline__ void run_gemm(LAS unsigned char* lds, const bf16_t* A, const bf16_t* Bt, int M, int N, int K, const Epi& E, int wgm = WGM_DEFAULT, int Kloop = 0) {
    asm volatile("" : "+s"(M), "+s"(N), "+s"(K));
    pg8::Gemm g; g.A = A; g.Bt = Bt; g.M = M; g.N = N; g.K = K; { int kl = Kloop > 0 ? Kloop : K; asm volatile("" : "+s"(kl)); g.Kloop = kl; }
    pg8::StaticOrder S; S.init(M, N, (int)gridDim.x, bidx()); S.wgm = wgm;
    pg8::gemm_phase<Epi, pg8::StaticOrder, GEMM_ALIGN, GEMM_SP2>(lds, g, S, E);
}

__device__ __forceinline__ void tr_tile(const float* src, int N, int k0, int n0, bf16_t* dst, int ldd, int rmul, int radd, LAS float* tile) {
    const int tid = tidx();
#pragma unroll
    for (int i = 0; i < 8; ++i) { const int k = i * 8 + (tid >> 6), n = tid & 63; tile[k * 65 + n] = src[(size_t)(k0 + k) * N + n0 + n]; }
    __syncthreads();
    { const int n = tid >> 3, c = tid & 7; const LAS float* s = tile + (c * 8) * 65 + n;
      u32x4 o; o.x = pk2(s[0], s[65]); o.y = pk2(s[130], s[195]); o.z = pk2(s[260], s[325]); o.w = pk2(s[390], s[455]);
      *(u32x4*)(dst + (size_t)(rmul * (n0 + n) + radd) * ldd + k0 + c * 8) = o; }
    __syncthreads();
}
__device__ __forceinline__ void norm_rows(const float* in_lat, const float* in_ctx, int nrows, const float* gain, const float* mods_l, int jshift, int jscale, bf16_t* H, const float* PART, int nkpend, float* XCw) {
    const int lane = tidx() & 63, gw = bidx() * 8 + (tidx() >> 6), NGW = gridDim.x * 8;
    for (int row0 = gw; row0 < nrows; row0 += 4 * NGW) {
        f32x4 v[4][4];
#pragma unroll
        for (int q = 0; q < 4; ++q) { const int row = row0 + q * NGW;
            if (row < nrows) { const bool isctx = row >= TLAT; const float* src = isctx ? in_ctx + (size_t)(row - TLAT) * D : in_lat + (size_t)row * D;
#pragma unroll
                for (int j = 0; j < 4; ++j) v[q][j] = *(const f32x4*)(src + 4 * lane + 256 * j); } }
#pragma unroll
        for (int q = 0; q < 4; ++q) { const int row = row0 + q * NGW;
            if (row >= nrows) continue;
            const bool isctx = row >= TLAT; const int ci = isctx ? 4 : (row >> 13);
            const float* sh = mods_l + (size_t)ci * 9216 + jshift * 1024; const float* sc = mods_l + (size_t)ci * 9216 + jscale * 1024;
            if (isctx && nkpend > 0) {
                const float* pp = PART + (size_t)(row - TLAT) * D + 4 * lane;
                int k = 0;
                for (; k + 4 <= nkpend; k += 4) {
                    f32x4 t[4][4];
#pragma unroll
                    for (int kk = 0; kk < 4; ++kk)
#pragma unroll
                        for (int j = 0; j < 4; ++j) t[kk][j] = *(const f32x4*)(pp + (size_t)(k + kk) * TCTX * D + 256 * j);
#pragma unroll
                    for (int kk = 0; kk < 4; ++kk)
#pragma unroll
                        for (int j = 0; j < 4; ++j) v[q][j] += t[kk][j]; }
                for (; k < nkpend; ++k) {
#pragma unroll
                    for (int j = 0; j < 4; ++j) v[q][j] += *(const f32x4*)(pp + (size_t)k * TCTX * D + 256 * j); }
#pragma unroll
                for (int j = 0; j < 4; ++j) *(f32x4*)(XCw + (size_t)(row - TLAT) * D + 4 * lane + 256 * j) = v[q][j];
            }
            float s = 0.f;
#pragma unroll
            for (int j = 0; j < 4; ++j) s += (v[q][j][0] * v[q][j][0] + v[q][j][1] * v[q][j][1]) + (v[q][j][2] * v[q][j][2] + v[q][j][3] * v[q][j][3]);
            const float rstd = rsqrtf(wave_sum(s) * (1.f / D) + 1e-6f);
#pragma unroll
            for (int j = 0; j < 4; ++j) { const int c = 4 * lane + 256 * j;
                const f32x4 g = *(const f32x4*)(gain + c), a = *(const f32x4*)(sc + c), b = *(const f32x4*)(sh + c);
                f32x4 y = v[q][j] * rstd * g * (a + 1.0f) + b;
                u32x2 w; w.x = pk2(y[0], y[1]); w.y = pk2(y[2], y[3]);
                *(u32x2*)(H + (size_t)row * D + c) = w; }
        }
    }
}

__device__ __forceinline__ void hdn_task(PP P, int io, int L, int posblk, float* out, bf16_t* outb, LAS float* lds, const LAS float* wl) {
    const int tid = tidx(), pp = tid >> 6, u = tid & 63, pos = posblk * 8 + pp;
    LAS float* feat = lds; LAS float* h1 = lds + 512; LAS float* h2 = lds + 1024;
    if (u < 33) {
        float f;
        if (u == 0) f = (float)pos / (float)(L - 1);
        else { const int bi = (u - 1) & 15; const float band = 1e-4f + (float)bi * ((15.0f - 1e-4f) / 15.0f); const float ang = 6.283185307179586f * (float)pos / (float)L;
               f = (u <= 16) ? cosf(band * ang) : -sinf(band * ang); }
        feat[pp * 36 + u] = f;
    }
    __syncthreads();
    const float fr = P->in[I_OFREQ][io * 64 + u];
    { float acc = P->in[I_OFB1][io * 64 + u];
#pragma unroll
      for (int f = 0; f < 33; ++f) acc += feat[pp * 36 + f] * wl[f * 64 + u];
      h1[pp * 64 + u] = sinf(fr * acc); }
    __syncthreads();
    { float acc = P->in[I_OFB2][io * 64 + u];
#pragma unroll 16
      for (int k = 0; k < 64; ++k) acc += h1[pp * 64 + k] * wl[2112 + k * 64 + u];
      h2[pp * 64 + u] = sinf(fr * acc); }
    __syncthreads();
    { float acc = P->in[I_OFB3][io * 64 + u];
#pragma unroll 16
      for (int k = 0; k < 64; ++k) acc += h2[pp * 64 + k] * wl[6208 + k * 64 + u];
      const float hv = sinf(fr * acc); out[(size_t)pos * 64 + u] = hv; if (outb) outb[(size_t)pos * 64 + u] = f2bf(hv); }
    __syncthreads();
}
__device__ __forceinline__ void prep_a(PP P, LAS float* lds) {
    const int tid = tidx();
    float* part = (float*)(P->ws + OFF_MPART);
    for (int task = bidx(); task < 4 * 18 * 8; task += gridDim.x) {
        const int ks = task & 7, nb = (task >> 3) % 18, l = task / 144;
        for (int idx = tid; idx < 640; idx += NTHREADS) { const int ci = idx >> 7, k = idx & 127;
            const float cv = ci < 4 ? P->in[I_C][ci * 1024 + ks * 128 + k] : P->in[I_CCTX][ks * 128 + k];
            lds[idx] = cv / (1.f + expf(-cv)); }
        __syncthreads();
        const int n = nb * 512 + tid; float a0 = 0.f, a1 = 0.f, a2 = 0.f, a3 = 0.f, a4 = 0.f;
        const float* w = P->in[I_ADAW] + ((size_t)l * 1024 + ks * 128) * 9216 + n;
#pragma unroll 32
        for (int k = 0; k < 128; ++k) { const float wv = w[(size_t)k * 9216];
            a0 += lds[k] * wv; a1 += lds[128 + k] * wv; a2 += lds[256 + k] * wv; a3 += lds[384 + k] * wv; a4 += lds[512 + k] * wv; }
        float* po = part + ((size_t)(ks * 4 + l) * 5) * 9216 + n;
        po[0] = a0; po[9216] = a1; po[2 * 9216] = a2; po[3 * 9216] = a3; po[4 * 9216] = a4;
        __syncthreads();
    }
    { float* XCp = (float*)(P->ws + OFF_XC); const float* cx = P->in[I_CTX];
      for (int idx = bidx() * NTHREADS + tid; idx < TCTX * D / 4; idx += gridDim.x * NTHREADS) ((f32x4*)XCp)[idx] = ((const f32x4*)cx)[idx]; }
    float* hdn = (float*)(P->ws + OFF_HDN); float* hdnc = (float*)(P->ws + OFF_HDNC);
    LAS float* wl = lds + 2048; int cur_io = -1;
    for (int task = bidx(); task < 2 * 1024 + 32; task += gridDim.x) {
        const int io = task < 2048 ? (task >> 10) : 0;
        if (io != cur_io) { __syncthreads();
            for (int idx = tid; idx < 33 * 64; idx += NTHREADS) wl[idx] = P->in[I_OFW1][(size_t)io * 33 * 64 + idx];
            for (int idx = tid; idx < 4096; idx += NTHREADS) { wl[2112 + idx] = P->in[I_OFW2][(size_t)io * 4096 + idx]; wl[6208 + idx] = P->in[I_OFW3][(size_t)io * 4096 + idx]; }
            cur_io = io; __syncthreads(); }
        if (task < 2048) hdn_task(P, io, 8192, task & 1023, hdn + (size_t)io * 8192 * 64, (bf16_t*)(P->ws + OFF_HDNB) + (size_t)io * 8192 * 64, lds, wl);
        else hdn_task(P, 0, 256, task - 2048, hdnc, nullptr, lds, wl);
    }
}
__device__ __forceinline__ void prep_b(PP P) {
    const float* part = (const float*)(P->ws + OFF_MPART); float* mods = (float*)(P->ws + OFF_MODS);
    for (int idx = bidx() * NTHREADS + tidx(); idx < 4 * 5 * 9216; idx += gridDim.x * NTHREADS) {
        const int n = idx % 9216, l = idx / (5 * 9216);
        float s = P->in[I_ADAB][l * 9216 + n];
#pragma unroll
        for (int ks = 0; ks < 8; ++ks) s += part[(size_t)ks * 4 * 5 * 9216 + idx];
        mods[idx] = s;
    }
}
__device__ __forceinline__ void conv_weights(PP P, int l, LAS float* tile) {
    const int i = l >> 1; const bool even = (l & 1) == 0;
    bf16_t* W1 = (bf16_t*)(P->ws + OFF_W1); bf16_t* W2 = (bf16_t*)(P->ws + OFF_W2); char* WM = P->ws + OFF_WMIX;
    const int nmix = even ? (608 + 64 + 256) : (768 + 256);
    const int ntiles = 6 * 704 + nmix;
    struct TD { const float* src; int N, k0, n0; bf16_t* dst; int ldd, rmul, radd; };
    auto decode = [&](int t) -> TD { TD d;
        if (t < 6 * 704) {
            const int mtx = t / 704, r = t % 704, hf = mtx / 3, kind = mtx % 3;
            if (kind < 2) { d.src = P->in[kind == 0 ? I_WG : I_WU] + (size_t)(l * 2 + hf) * 1024 * DFF; d.N = DFF; d.k0 = (r / 44) * 64; d.n0 = (r % 44) * 64;
                d.dst = W1 + (size_t)hf * 5632 * 1024; d.ldd = 1024; d.rmul = 1; d.radd = (d.n0 >> 7) * 256 + (d.n0 & 127) + kind * 128 - d.n0; }
            else { d.src = P->in[I_WD] + (size_t)(l * 2 + hf) * DFF * 1024; d.N = 1024; d.k0 = (r / 16) * 64; d.n0 = (r % 16) * 64;
                d.dst = W2 + (size_t)hf * 1024 * DFF; d.ldd = DFF; d.rmul = 1; d.radd = 0; }
        } else {
            int r = t - 6 * 704; d.rmul = 1; d.radd = 0;
            if (even) {
                if (r < 608) { d.src = P->in[I_EWIN] + (size_t)i * 1024 * 2432; d.N = 2432; d.k0 = (r / 38) * 64; d.n0 = (r % 38) * 64; d.dst = (bf16_t*)(WM + WM_EWIN); d.ldd = 1024; d.radd = d.n0 < 1920 ? 512 : -1920; }
                else if (r < 672) { r -= 608; d.src = P->in[I_EWGLU] + (size_t)i * 512 * 512; d.N = 512; d.k0 = (r >> 3) * 64; d.n0 = (r & 7) * 64; d.dst = (bf16_t*)(WM + WM_EGLU); d.ldd = 512; }
                else { r -= 672; d.src = P->in[I_EWOUT] + (size_t)i * 1024 * 1024; d.N = 1024; d.k0 = (r >> 4) * 64; d.n0 = (r & 15) * 64; d.dst = (bf16_t*)(WM + WM_EOUT); d.ldd = 1024; }
            } else {
                if (r < 768) { d.src = P->in[I_OWIN] + (size_t)i * 1024 * 3072; d.N = 3072; d.k0 = (r / 48) * 64; d.n0 = (r % 48) * 64; d.dst = (bf16_t*)(WM + WM_OWIN); d.ldd = 1024; }
                else { r -= 768; d.src = P->in[I_OWOUT] + (size_t)i * 1024 * 1024; d.N = 1024; d.k0 = (r >> 4) * 64; d.n0 = (r & 15) * 64; d.dst = (bf16_t*)(WM + WM_OOUT); d.ldd = 1024; }
            }
        }
        return d; };
    const int tid = tidx();
    auto tload = [&](const TD& d, float (&r)[8]) {
#pragma unroll
        for (int q = 0; q < 8; ++q) r[q] = d.src[(size_t)(d.k0 + q * 8 + (tid >> 6)) * d.N + d.n0 + (tid & 63)]; };
    auto tstore = [&](const TD& d, const float (&r)[8]) {
#pragma unroll
        for (int q = 0; q < 8; ++q) tile[(q * 8 + (tid >> 6)) * 65 + (tid & 63)] = r[q];
        __syncthreads();
        { const int n = tid >> 3, c = tid & 7; const LAS float* sp = tile + (c * 8) * 65 + n;
          u32x4 o; o.x = pk2(sp[0], sp[65]); o.y = pk2(sp[130], sp[195]); o.z = pk2(sp[260], sp[325]); o.w = pk2(sp[390], sp[455]);
          *(u32x4*)(d.dst + (size_t)(d.rmul * (d.n0 + n) + d.radd) * d.ldd + d.k0 + c * 8) = o; }
        __syncthreads(); };
    { int t = bidx(); TD cur, nxt; float rc[8], rn[8];
      if (t < ntiles) { cur = decode(t); tload(cur, rc); }
      while (t < ntiles) { const int tn = t + (int)gridDim.x;
          if (tn < ntiles) { nxt = decode(tn); tload(nxt, rn); }
          tstore(cur, rc);
          cur = nxt;
#pragma unroll
          for (int q = 0; q < 8; ++q) rc[q] = rn[q];
          t = tn; } }
    if (even) {
        bf16_t* WL = (bf16_t*)(WM + WM_ELORA);
        for (int idx = bidx() * NTHREADS + tidx(); idx < 2560 * 384; idx += gridDim.x * NTHREADS) {
            const int n = idx / 384, k = idx % 384, type = n >> 9, c = n & 511; float v = 0.f;
            if (type == 0 && k < 64) v = P->in[I_EWUP][((size_t)(i * 2 + 0) * 64 + k) * 512 + c];
            else if (type == 1 && k >= 64 && k < 128) v = P->in[I_EWUP][((size_t)(i * 2 + 1) * 64 + (k - 64)) * 512 + c];
            else if (type == 2 && k >= 128 && k < 192) v = P->in[I_EAUP][((size_t)(i * 2 + 0) * 64 + (k - 128)) * 512 + c];
            else if (type == 3 && k >= 192 && k < 256) v = P->in[I_EAUP][((size_t)(i * 2 + 1) * 64 + (k - 192)) * 512 + c];
            else if (type == 4 && k >= 256) v = P->in[I_EGUP][((size_t)i * 128 + (k - 256)) * 512 + c];
            WL[idx] = f2bf(v);
        }
    }
}
__device__ __forceinline__ void feat_phase(PP P, int i) {
    const int lane = tidx() & 63, gw = bidx() * 8 + (tidx() >> 6), NGW = gridDim.x * 8;
    char* big = P->ws + OFF_BIG;
    const bf16_t* PR = (const bf16_t*)(big + B_PR);
    bf16_t* R = (bf16_t*)(big + B_RVK); bf16_t* KR = R + SE; bf16_t* V = R + 2 * SE; bf16_t* KK = R + 3 * SE; bf16_t* LIN = (bf16_t*)(big + B_LORA);
    const float* mu = P->in[I_EMU] + (size_t)i * 1920; const float* k_k = P->in[I_EKK] + (size_t)i * 512;
    for (int row = gw; row < TT; row += NGW) {
        int r0, r1, r2, r3;
        if (row < TLAT) { const int t = row & 8191, x = t & 63, y = t >> 6;
            r0 = x > 0 ? row - 1 : -1; r1 = x < 63 ? row + 1 : -1; r2 = y > 0 ? row - 64 : -1; r3 = y < 127 ? row + 64 : -1; }
        else { const int t = (row - TLAT) & 255; r0 = t > 0 ? row - 1 : -1; r1 = t < 255 ? row + 1 : -1; r2 = r0; r3 = r1; }
        u32x2 pwv[8]; unsigned short nb[8][4];
#pragma unroll
        for (int it = 0; it < 8; ++it) {
            const int gi = it * 64 + lane; const bool act = gi < 480; const int c0 = act ? 4 * gi : 0;
            pwv[it] = *(const u32x2*)(PR + (size_t)row * 2048 + c0);
            nb[it][0] = r0 >= 0 ? PR[(size_t)r0 * 2048 + c0 + 0] : (unsigned short)0;
            nb[it][1] = r1 >= 0 ? PR[(size_t)r1 * 2048 + c0 + 1] : (unsigned short)0;
            nb[it][2] = r2 >= 0 ? PR[(size_t)r2 * 2048 + c0 + 2] : (unsigned short)0;
            nb[it][3] = r3 >= 0 ? PR[(size_t)r3 * 2048 + c0 + 3] : (unsigned short)0;
        }
#pragma unroll
        for (int it = 0; it < 8; ++it) {
            const int gi = it * 64 + lane; const bool act = gi < 480; const int c0 = act ? 4 * gi : 0;
            const u32x2 pw = pwv[it];
            float p[4] = {lo16(pw.x), hi16(pw.x), lo16(pw.y), hi16(pw.y)};
            float pn[4] = {bf2f(nb[it][0]), bf2f(nb[it][1]), bf2f(nb[it][2]), bf2f(nb[it][3])};
            const f32x4 m4 = *(const f32x4*)(mu + c0);
            float q[4];
#pragma unroll
            for (int j = 0; j < 4; ++j) q[j] = p[j] + m4[j] * (pn[j] - p[j]);
            const bool isk = act && c0 >= 512 && c0 < 1024;
            float kr4[4] = {0.f, 0.f, 0.f, 0.f}; float ss = 0.f;
            if (isk) { const f32x4 kk4 = *(const f32x4*)(k_k + (c0 - 512));
#pragma unroll
                for (int j = 0; j < 4; ++j) { kr4[j] = q[j] * kk4[j]; ss += kr4[j] * kr4[j]; } }
            ss = red16(ss);
            if (!act) continue;
            if (c0 < 512) { u32x2 w; w.x = pk2(q[0], q[1]); w.y = pk2(q[2], q[3]); *(u32x2*)(R + (size_t)row * 512 + c0) = w; }
            else if (c0 < 1024) { u32x2 w; w.x = pk2(q[0], q[1]); w.y = pk2(q[2], q[3]); *(u32x2*)(KR + (size_t)row * 512 + (c0 - 512)) = w;
                const float inv = 1.f / fmaxf(sqrtf(ss), 1e-12f);
                w.x = pk2(kr4[0] * inv, kr4[1] * inv); w.y = pk2(kr4[2] * inv, kr4[3] * inv); *(u32x2*)(KK + (size_t)row * 512 + (c0 - 512)) = w; }
            else if (c0 < 1536) { u32x2 w; w.x = pk2(q[0], q[1]); w.y = pk2(q[2], q[3]); *(u32x2*)(V + (size_t)row * 512 + (c0 - 1024)) = w; }
            else { float o[4];
                if (c0 < 1664) {
#pragma unroll
                    for (int j = 0; j < 4; ++j) o[j] = tanhf(q[j]); }
                else if (c0 < 1792) {
#pragma unroll
                    for (int j = 0; j < 4; ++j) o[j] = q[j]; }
                else {
#pragma unroll
                    for (int j = 0; j < 4; ++j) o[j] = sigm(q[j]); }
                u32x2 w; w.x = pk2(o[0], o[1]); w.y = pk2(o[2], o[3]); *(u32x2*)(LIN + (size_t)row * 384 + (c0 - 1536)) = w; }
        }
    }
}
constexpr int SST = 340;
constexpr int CH = 32;
constexpr int NCHUNK = (CTXL + SEQ) / CH;
__device__ __forceinline__ int row_of_step(int s, int b, int dir) {
    if (s < CTXL) { const int t = dir ? (CTXL - 1 - s) : s; return TLAT + b * CTXL + t; }
    const int t = dir ? (SEQ - 1 - (s - CTXL)) : (s - CTXL); return b * SEQ + t;
}
__device__ __forceinline__ void scan_phase(PP P, int i, LAS unsigned char* ldsb) {
    const int tid = tidx(), wave = tid >> 6, lane = tid & 63;
    char* big = P->ws + OFF_BIG;
    const bf16_t* R = (const bf16_t*)(big + B_RVK); const bf16_t* KR = R + SE; const bf16_t* V = R + 2 * SE; const bf16_t* KK = R + 3 * SE;
    const bf16_t* EA = (const bf16_t*)(big + B_PR); const bf16_t* U = (const bf16_t*)(big + B_U);
    bf16_t* O = (bf16_t*)(big + B_O); bf16_t* YS = (bf16_t*)(big + B_YS);
    LAS float* sbuf = (LAS float*)ldsb;
    LAS float* bul = (LAS float*)(ldsb + 2 * CH * SST * 4);
    LAS bf16_t* hbl = (LAS bf16_t*)(ldsb + 2 * CH * SST * 4 + 16 * 132 * 4);
    for (int item = bidx(); item < 256; item += gridDim.x) {
        const int vi = (item & 7) * 32 + (item >> 3);
        const int b = vi >> 6, head = (vi >> 3) & 7, dir = (vi >> 2) & 1, rq = vi & 3, g = head * 4 + rq;
        const bf16_t* Ed = EA + (size_t)dir * SE; const bf16_t* Ad = EA + (size_t)(2 + dir) * SE;
        bf16_t* Od = O + (size_t)dir * SE; bf16_t* YSd = YS + (size_t)dir * SE;
        pg8::f32x2 sA = {0.f, 0.f}, sB = {0.f, 0.f};
        const int rl = lane >> 4, cg4 = (lane & 15) * 4, il = (wave & 3) * 4 + rl;
        float hre = 0.f, him = 0.f, are = 0.f, aim = 0.f;
        bf16x8 unx = {0, 0, 0, 0, 0, 0, 0, 0};
        LAS float* bul = (LAS float*)(ldsb + 87040);
        LAS bf16_t* hbl = (LAS bf16_t*)(ldsb + 120832);
        LAS bf16x8* bfl = (LAS bf16x8*)(ldsb + 138240); LAS bf16x8* cfl = (LAS bf16x8*)(ldsb + 146432);
        const int kq = lane >> 4, l15 = lane & 15;
        __syncthreads();
        if (wave == 7) {
            const int dg = ((i * 2 + dir) * 32 + g);
            const float lre = P->in[I_ELRE][dg * 64 + lane], lim = P->in[I_ELIM][dg * 64 + lane];
            const float dt = expf(P->in[I_ELOGDT][dg]);
            const float er = expf(lre * dt); float sn, cs; sincosf(lim * dt, &sn, &cs);
            are = er * cs; aim = er * sn;
            const float xr = are - 1.f, xi = aim, den = 1.f / (lre * lre + lim * lim);
            const float czr = (xr * lre + xi * lim) * den, czi = (xi * lre - xr * lim) * den;
#pragma unroll 1
            for (int nt = 0; nt < 8; ++nt) {
                const int col = nt * 16 + l15, pp = col >> 1, part = col & 1;
                const float cr = __shfl(czr, pp), cim = __shfl(czi, pp);
                bf16x8 f;
#pragma unroll
                for (int j = 0; j < 8; ++j) { float v = 0.f;
                    if (kq < 2) { const int h = kq * 8 + j; const float br = P->in[I_EBRE][((size_t)dg * 64 + pp) * 16 + h], bi = P->in[I_EBIM][((size_t)dg * 64 + pp) * 16 + h];
                        v = part ? (cr * bi + cim * br) : (cr * br - cim * bi); }
                    f[j] = (short)f2bf(v); }
                bfl[nt * 64 + lane] = f;
            }
#pragma unroll 1
            for (int kb = 0; kb < 4; ++kb) { bf16x8 f;
#pragma unroll
                for (int j = 0; j < 8; ++j) { const int k = kb * 32 + kq * 8 + j, pp = k >> 1;
                    const float v = (k & 1) ? -P->in[I_ECIM][((size_t)dg * 16 + l15) * 64 + pp] : P->in[I_ECRE][((size_t)dg * 16 + l15) * 64 + pp];
                    f[j] = (short)f2bf(v); }
                cfl[kb * 64 + lane] = f; }
        }
        __syncthreads();
        const int bsub = wave & 1;
        auto uload = [&](int chunk) { const int row = row_of_step(chunk * CH + bsub * 16 + l15, b, dir);
            bf16x8 z = {0, 0, 0, 0, 0, 0, 0, 0}; if (kq < 2) z = *(const bf16x8*)(U + (size_t)row * 512 + g * 16 + kq * 8); unx = z; };
        auto bu_chunk = [&](int chunk) { LAS float* bw = bul + ((chunk & 1) * 2 + bsub) * (16 * 132);
#pragma unroll
            for (int nt = 0; nt < 8; ++nt) { f32x4 acc = {0.f, 0.f, 0.f, 0.f};
                acc = __builtin_amdgcn_mfma_f32_16x16x32_bf16(unx, bfl[nt * 64 + lane], acc, 0, 0, 0);
#pragma unroll
                for (int r = 0; r < 4; ++r) bw[(kq * 4 + r) * 132 + nt * 16 + l15] = acc[r]; } };
        auto s5_readout = [&](int chunk) { const LAS bf16_t* hb = hbl + (chunk & 1) * (32 * 136);
#pragma unroll
            for (int sub = 0; sub < 2; ++sub) { f32x4 accy = {0.f, 0.f, 0.f, 0.f};
#pragma unroll
                for (int kb = 0; kb < 4; ++kb) { const bf16x8 af = *(const LAS bf16x8*)(hb + (sub * 16 + l15) * 136 + kb * 32 + kq * 8);
                    accy = __builtin_amdgcn_mfma_f32_16x16x32_bf16(af, cfl[kb * 64 + lane], accy, 0, 0, 0); }
                const int row0 = row_of_step(chunk * CH + sub * 16 + kq * 4, b, dir); const int rstr = dir ? -512 : 512;
#pragma unroll
                for (int r = 0; r < 4; ++r) YSd[(ptrdiff_t)row0 * 512 + (ptrdiff_t)r * rstr + g * 16 + l15] = f2bf(accy[r]); } };
        const float* k_a = P->in[I_EKA] + (size_t)i * 512 + head * 64;
        struct SG { u32x4 r, k, v, kk, e, a; };
        SG g0, g1; g0.r = (u32x4){0u, 0u, 0u, 0u}; g0.k = g0.r; g0.v = g0.r; g0.kk = g0.r; g0.e = g0.r; g0.a = g0.r; g1 = g0;
        const int item0 = wave < 6 ? ((wave & 1) * 64 + lane) : (128 + lane), item1 = 192 + lane;
        const int sstp0 = item0 >> 3, sstp1 = item1 >> 3, oct = lane & 7;
        const bool st_a = (wave >= 4 && wave < 7), st_b = (wave == 6);
        f32x4 ka0 = {0.f, 0.f, 0.f, 0.f}, ka1 = ka0;
        if (tid >= 256) { ka0 = *(const f32x4*)(k_a + oct * 8); ka1 = *(const f32x4*)(k_a + oct * 8 + 4); }
        auto sload1 = [&](SG& q, int sstp, int chunk) {
            const int row = row_of_step(chunk * CH + sstp, b, dir); const size_t off = (size_t)row * 512 + head * 64 + oct * 8;
            q.r = *(const u32x4*)(R + off); q.k = *(const u32x4*)(KR + off); q.v = *(const u32x4*)(V + off); q.kk = *(const u32x4*)(KK + off);
            q.e = *(const u32x4*)(Ed + off); q.a = *(const u32x4*)(Ad + off); };
        auto sload = [&](int chunk) { if (st_a) sload1(g0, sstp0, chunk); if (st_b) sload1(g1, sstp1, chunk); };
        auto sconv1 = [&](const SG& q, int sstp, LAS float* buf) {
            const u32x4 gR = q.r, gK = q.k, gV = q.v, gKK = q.kk, gE = q.e, gA = q.a;
            LAS float* p = buf + sstp * SST + oct * 8;
            float krp = 0.f, brp = 0.f; f32x4 okk[2], ow[2], okd[2], obb[2], owr[2], ov[2];
#pragma unroll
            for (int h2 = 0; h2 < 2; ++h2) {
                const unsigned wR0 = h2 ? gR.z : gR.x, wR1 = h2 ? gR.w : gR.y, wK0 = h2 ? gK.z : gK.x, wK1 = h2 ? gK.w : gK.y, wV0 = h2 ? gV.z : gV.x, wV1 = h2 ? gV.w : gV.y;
                const unsigned wQ0 = h2 ? gKK.z : gKK.x, wQ1 = h2 ? gKK.w : gKK.y, wE0 = h2 ? gE.z : gE.x, wE1 = h2 ? gE.w : gE.y, wA0 = h2 ? gA.z : gA.x, wA1 = h2 ? gA.w : gA.y;
                const float r4[4] = {lo16(wR0), hi16(wR0), lo16(wR1), hi16(wR1)}, k4[4] = {lo16(wK0), hi16(wK0), lo16(wK1), hi16(wK1)};
                const float q4[4] = {lo16(wQ0), hi16(wQ0), lo16(wQ1), hi16(wQ1)}, e4[4] = {lo16(wE0), hi16(wE0), lo16(wE1), hi16(wE1)}, a4[4] = {lo16(wA0), hi16(wA0), lo16(wA1), hi16(wA1)};
                const f32x4 kav = h2 ? ka1 : ka0;
                ov[h2] = (f32x4){lo16(wV0), hi16(wV0), lo16(wV1), hi16(wV1)};
#pragma unroll
                for (int j = 0; j < 4; ++j) { const float w = __expf(-e4[j]), kd = k4[j] * (1.f + (a4[j] - 1.f) * kav[j]), bb = q4[j] * a4[j];
                    okk[h2][j] = q4[j]; ow[h2][j] = w; okd[h2][j] = kd; obb[h2][j] = bb; owr[h2][j] = w * r4[j]; krp += kd * r4[j]; brp += bb * r4[j]; }
            }
            krp += __shfl_xor(krp, 1); brp += __shfl_xor(brp, 1); krp += __shfl_xor(krp, 2); brp += __shfl_xor(brp, 2); krp += __shfl_xor(krp, 4); brp += __shfl_xor(brp, 4);
            *(LAS f32x4*)(p) = okk[0]; *(LAS f32x4*)(p + 4) = okk[1]; *(LAS f32x4*)(p + 64) = ow[0]; *(LAS f32x4*)(p + 68) = ow[1];
            *(LAS f32x4*)(p + 128) = okd[0]; *(LAS f32x4*)(p + 132) = okd[1]; *(LAS f32x4*)(p + 192) = obb[0]; *(LAS f32x4*)(p + 196) = obb[1];
            *(LAS f32x4*)(p + 256) = owr[0]; *(LAS f32x4*)(p + 260) = owr[1];
            if ((oct >> 1) == rq) { LAS float* pv = buf + sstp * SST + 320 + (oct & 1) * 8; *(LAS f32x4*)(pv) = ov[0]; *(LAS f32x4*)(pv + 4) = ov[1]; }
            if (oct == 0) { buf[sstp * SST + 336] = krp * 0.0625f; buf[sstp * SST + 337] = brp * 0.0625f; }
        };
        auto sconvert = [&](LAS float* buf) { if (st_a) sconv1(g0, sstp0, buf); if (st_b) sconv1(g1, sstp1, buf); };
        if (tid >= 256) { sload(0); sconvert(sbuf); sload(1); }
        if (wave == 4 || wave == 5) { uload(0); bu_chunk(0); uload(1); }
        __syncthreads();
        for (int c = 0; c < NCHUNK; ++c) {
            LAS float* buf = sbuf + (c & 1) * CH * SST;
            if (wave < 4) {
                __builtin_amdgcn_s_setprio(3);
                const int orow0 = row_of_step(c * CH, b, dir); const int ostr = dir ? -512 : 512;
                bf16_t* op = Od + (size_t)orow0 * 512 + head * 64 + rq * 16 + il;
                const LAS float* pb = buf;
                f32x4 nkk = *(const LAS f32x4*)(pb + cg4), nw = *(const LAS f32x4*)(pb + 64 + cg4), nkd = *(const LAS f32x4*)(pb + 128 + cg4),
                      nbb = *(const LAS f32x4*)(pb + 192 + cg4), nwr = *(const LAS f32x4*)(pb + 256 + cg4);
                float nv = pb[320 + il]; pg8::f32x2 nkb = *(const LAS pg8::f32x2*)(pb + 336);
#pragma unroll
                for (int hb = 0; hb < CH / 16; ++hb) {
                    float qv[16];
#pragma unroll
                    for (int s16 = 0; s16 < 16; ++s16) {
                        const f32x4 kk = nkk, w = nw, kd = nkd, bb = nbb, wr = nwr; const float v = nv, kr = nkb.x, br = nkb.y;
                        const LAS float* p = buf + (hb * 16 + s16 + 1) * SST;
                        nkk = *(const LAS f32x4*)(p + cg4); nw = *(const LAS f32x4*)(p + 64 + cg4); nkd = *(const LAS f32x4*)(p + 128 + cg4);
                        nbb = *(const LAS f32x4*)(p + 192 + cg4); nwr = *(const LAS f32x4*)(p + 256 + cg4); nv = p[320 + il]; nkb = *(const LAS pg8::f32x2*)(p + 336);
                        __builtin_amdgcn_sched_barrier(0);
                        typedef pg8::f32x2 v2;
                        const v2 kkA = {kk[0], kk[1]}, kkB = {kk[2], kk[3]}, wrA = {wr[0], wr[1]}, wrB = {wr[2], wr[3]};
                        v2 t1 = sA * kkA; t1 = __builtin_elementwise_fma(sB, kkB, t1);
                        v2 t2 = sA * wrA; t2 = __builtin_elementwise_fma(sB, wrB, t2);
                        float p1 = t1.x + t1.y; const float p2 = t2.x + t2.y;
                        p1 = red16(p1);
                        qv[s16] = p2 + (v * kr - p1 * br);
                        const v2 wA = {w[0], w[1]}, wB = {w[2], w[3]}, kdA = {kd[0], kd[1]}, kdB = {kd[2], kd[3]}, bbA = {bb[0], bb[1]}, bbB = {bb[2], bb[3]};
                        const v2 vv = {v, v}, pp = {p1, p1};
                        v2 uA = bbA * pp; uA = __builtin_elementwise_fma(kdA, vv, -uA); sA = __builtin_elementwise_fma(sA, wA, uA);
                        v2 uB = bbB * pp; uB = __builtin_elementwise_fma(kdB, vv, -uB); sB = __builtin_elementwise_fma(sB, wB, uB);
                        __builtin_amdgcn_sched_barrier(0);
                    }
                    const bool b3 = (lane & 8) != 0, b2 = (lane & 4) != 0, b1 = (lane & 2) != 0, b0 = (lane & 1) != 0;
                    float r8[8], r4[4], r2[2];
#pragma unroll
                    for (int j = 0; j < 8; ++j) { const float kp = b3 ? qv[j + 8] : qv[j], sd = b3 ? qv[j] : qv[j + 8]; r8[j] = kp + dpp_mov<0x140>(sd); }
#pragma unroll
                    for (int j = 0; j < 4; ++j) { const float kp = b2 ? r8[j + 4] : r8[j], sd = b2 ? r8[j] : r8[j + 4]; r4[j] = kp + dpp_mov<0x141>(sd); }
#pragma unroll
                    for (int j = 0; j < 2; ++j) { const float kp = b1 ? r4[j + 2] : r4[j], sd = b1 ? r4[j] : r4[j + 2]; r2[j] = kp + dpp_mov<0x1B>(sd); }
                    const float keep = (b0 ? r2[1] : r2[0]) + dpp_mov<0xB1>(b0 ? r2[0] : r2[1]);
                    op[(ptrdiff_t)(hb * 16 + (lane & 15)) * ostr] = f2bf(keep);
                }
                __builtin_amdgcn_s_setprio(0);
            } else {
                if (c + 1 < NCHUNK) sconvert(sbuf + ((c + 1) & 1) * CH * SST);
                if (c + 2 < NCHUNK) sload(c + 2);
            }
            if (wave == 4 || wave == 5) { if (c + 1 < NCHUNK) bu_chunk(c + 1); if (c + 2 < NCHUNK) uload(c + 2); }
            else if (wave == 7) {
                const LAS float* br_ = bul + (c & 1) * 2 * (16 * 132); LAS unsigned* hw = (LAS unsigned*)(hbl + (c & 1) * (32 * 136));
#pragma unroll 8
                for (int tl = 0; tl < 32; ++tl) { const pg8::f32x2 bv = *(const LAS pg8::f32x2*)(br_ + tl * 132 + 2 * lane);
                    const float nr = are * hre - aim * him + bv.x, ni = are * him + aim * hre + bv.y; hre = nr; him = ni;
                    hw[tl * 68 + lane] = cvt_pk_bf16(hre, him); }
                if (c > 0) s5_readout(c - 1);
            }
            __syncthreads();
        }
        if (wave == 7) s5_readout(NCHUNK - 1);
    }
}
__device__ __forceinline__ void read_phase(PP P, int i, int nrows) {
    const int lane = tidx() & 63, gw = bidx() * 8 + (tidx() >> 6), NGW = gridDim.x * 8;
    char* big = P->ws + OFF_BIG;
    const bf16_t* R = (const bf16_t*)(big + B_RVK); const bf16_t* KR = R + SE; const bf16_t* V = R + 2 * SE;
    const bf16_t* EA = (const bf16_t*)(big + B_PR); const bf16_t* Af = EA + 2 * SE; const bf16_t* Ab = EA + 3 * SE; const bf16_t* G = (const bf16_t*)(big + B_G);
    const bf16_t* U = (const bf16_t*)(big + B_U); const bf16_t* Of = (const bf16_t*)(big + B_O); const bf16_t* Ob = Of + SE;
    bf16_t* YSf = (bf16_t*)(big + B_YS); const bf16_t* YSb = YSf + SE; bf16_t* YCAT = (bf16_t*)(P->ws + OFF_H);
    const float* k_a = P->in[I_EKA] + (size_t)i * 512; const float* r_k = P->in[I_ERK] + (size_t)i * 512;
    const float* gn_g = P->in[I_EGNG] + (size_t)i * 512; const float* gn_b = P->in[I_EGNB] + (size_t)i * 512; const float* dsk = P->in[I_ED] + (size_t)i * 512;
    for (int row = gw; row < nrows; row += NGW) {
        unsigned short ld[8][9];
#pragma unroll
        for (int h = 0; h < 8; ++h) { const size_t off = (size_t)row * 512 + h * 64 + lane;
            ld[h][0] = Of[off]; ld[h][1] = Ob[off]; ld[h][2] = R[off]; ld[h][3] = KR[off]; ld[h][4] = V[off]; ld[h][5] = Af[off]; ld[h][6] = Ab[off]; ld[h][7] = G[off]; }
#pragma unroll
        for (int h = 0; h < 8; ++h) { const int c = h * 64 + lane;
            const float o = bf2f(ld[h][0]) + bf2f(ld[h][1]);
            const float mean = wave_sum(o) * (1.f / 64.f); const float dlt = o - mean; const float var = wave_sum(dlt * dlt) * (1.f / 64.f);
            const float on = dlt * rsqrtf(var + 64e-5f);
            const float r = bf2f(ld[h][2]), kraw = bf2f(ld[h][3]), v = bf2f(ld[h][4]), af = bf2f(ld[h][5]), ab = bf2f(ld[h][6]), gg = bf2f(ld[h][7]);
            const float ka = k_a[c]; const float kds = kraw * ((1.f + (af - 1.f) * ka) + (1.f + (ab - 1.f) * ka));
            const float dot = wave_sum(r * kds * r_k[c]);
            YCAT[(size_t)row * 1024 + c] = f2bf((on * gn_g[c] + gn_b[c] + dot * v) * gg);
        }
        { const int c0 = lane * 8; const size_t off = (size_t)row * 512 + c0;
          const u32x4 yf = *(const u32x4*)(YSf + off), yb = *(const u32x4*)(YSb + off), uu = *(const u32x4*)(U + off);
          float y[8] = {lo16(yf.x) + lo16(yb.x), hi16(yf.x) + hi16(yb.x), lo16(yf.y) + lo16(yb.y), hi16(yf.y) + hi16(yb.y),
                        lo16(yf.z) + lo16(yb.z), hi16(yf.z) + hi16(yb.z), lo16(yf.w) + lo16(yb.w), hi16(yf.w) + hi16(yb.w)};
          const float uv[8] = {lo16(uu.x), hi16(uu.x), lo16(uu.y), hi16(uu.y), lo16(uu.z), hi16(uu.z), lo16(uu.w), hi16(uu.w)};
#pragma unroll
          for (int j = 0; j < 8; ++j) { const float t = y[j] + dsk[c0 + j] * uv[j]; y[j] = 0.5f * t * (1.f + tanhf(0.7978845608f * (t + 0.044715f * t * t * t))); }
          u32x4 w; w.x = pk2(y[0], y[1]); w.y = pk2(y[2], y[3]); w.z = pk2(y[4], y[5]); w.w = pk2(y[6], y[7]);
          *(u32x4*)(YSf + off) = w; }
    }
}

constexpr int FN = 16384;
typedef float cf2 __attribute__((ext_vector_type(2)));
__device__ __forceinline__ cf2 mk2(float a, float b) { cf2 r; r.x = a; r.y = b; return r; }
__device__ __forceinline__ cf2 cadd(cf2 a, cf2 b) { return a + b; }
__device__ __forceinline__ cf2 csub(cf2 a, cf2 b) { return a - b; }
__device__ __forceinline__ cf2 cmul(cf2 a, cf2 b) { const cf2 br = mk2(-b.y, b.x); return __builtin_shufflevector(a, a, 0, 0) * b + __builtin_shufflevector(a, a, 1, 1) * br; }
__device__ __forceinline__ cf2 cmulc(cf2 a, cf2 b) { const cf2 bc = mk2(b.x, -b.y), bs = mk2(b.y, b.x); return __builtin_shufflevector(a, a, 0, 0) * bc + __builtin_shufflevector(a, a, 1, 1) * bs; }
__device__ __forceinline__ int SW(int i) { return i; }
__device__ __forceinline__ cf2 twid(int m) { const float x = (float)m * (1.0f / 16384.0f); return mk2(__builtin_amdgcn_cosf(x), -__builtin_amdgcn_sinf(x)); }
__device__ __forceinline__ cf2 rot_mi(cf2 z) { return mk2(z.y, -z.x); }
__device__ __forceinline__ cf2 rot_pi(cf2 z) { return mk2(-z.y, z.x); }
template <bool ZH> __device__ __forceinline__ void fft_fwd_pass_t(LAS cf2* S, int pass) {
    const int tid = tidx(); const float c = 0.70710678118654752f;
    if (pass < 4) {
        const int s = 3 * pass, el = 11 - s, e = 1 << el;
#pragma unroll 2
        for (int k = 0; k < 4; ++k) {
            const int gi = tid + 512 * k, grp = gi >> el, pos = gi & (e - 1), i0 = (grp << (el + 3)) + pos;
            cf2 x[8];
#pragma unroll
            for (int j = 0; j < 8; ++j) x[j] = (ZH && j >= 4) ? mk2(0.f, 0.f) : S[SW(i0 + j * e)];
            const cf2 w1 = twid(pos << s), w2 = cmul(w1, w1), w4 = cmul(w2, w2);
            const cf2 a0 = x[0] + x[4], a1 = x[1] + x[5], a2 = x[2] + x[6], a3 = x[3] + x[7];
            const cf2 d0 = x[0] - x[4], d1 = x[1] - x[5], d2 = x[2] - x[6], d3 = x[3] - x[7];
            const cf2 b0 = cmul(d0, w1), b1 = cmul(mk2((d1.x + d1.y) * c, (d1.y - d1.x) * c), w1), b2 = cmul(rot_mi(d2), w1), b3 = cmul(mk2((d3.y - d3.x) * c, (-d3.y - d3.x) * c), w1);
            const cf2 c0 = a0 + a2, c2 = cmul(a0 - a2, w2), c1 = a1 + a3, c3 = cmul(rot_mi(a1 - a3), w2);
            const cf2 g0 = b0 + b2, g2 = cmul(b0 - b2, w2), g1 = b1 + b3, g3 = cmul(rot_mi(b1 - b3), w2);
            S[SW(i0)] = c0 + c1; S[SW(i0 + e)] = cmul(c0 - c1, w4); S[SW(i0 + 2 * e)] = c2 + c3; S[SW(i0 + 3 * e)] = cmul(c2 - c3, w4);
            S[SW(i0 + 4 * e)] = g0 + g1; S[SW(i0 + 5 * e)] = cmul(g0 - g1, w4); S[SW(i0 + 6 * e)] = g2 + g3; S[SW(i0 + 7 * e)] = cmul(g2 - g3, w4);
        }
    } else {
#pragma unroll 4
        for (int k = 0; k < 8; ++k) {
            const int i0 = 4 * (tid + 512 * k);
            const cf2 x0 = S[SW(i0)], x1 = S[SW(i0 + 1)], x2 = S[SW(i0 + 2)], x3 = S[SW(i0 + 3)];
            const cf2 t0 = x0 + x2, t2 = x0 - x2, t1 = x1 + x3, t3 = rot_mi(x1 - x3);
            S[SW(i0)] = t0 + t1; S[SW(i0 + 1)] = t0 - t1; S[SW(i0 + 2)] = t2 + t3; S[SW(i0 + 3)] = t2 - t3;
        }
    }
}
template <bool LOW, bool KM> __device__ __forceinline__ void fft_inv_pass_t(LAS cf2* S, int pass, const cf2* Kp) {
    const int tid = tidx(); const float c = 0.70710678118654752f;
    if (pass < 4) {
        const int s = 3 * pass, el = 11 - s, e = 1 << el;
#pragma unroll 2
        for (int k = 0; k < 4; ++k) {
            const int gi = tid + 512 * k, grp = gi >> el, pos = gi & (e - 1), i0 = (grp << (el + 3)) + pos;
            cf2 y[8];
#pragma unroll
            for (int j = 0; j < 8; ++j) y[j] = S[SW(i0 + j * e)];
            const cf2 w1 = twid(pos << s), w2 = cmul(w1, w1), w4 = cmul(w2, w2);
            const cf2 q1 = cmulc(y[1], w4), q3 = cmulc(y[3], w4), q5 = cmulc(y[5], w4), q7 = cmulc(y[7], w4);
            const cf2 c0 = y[0] + q1, c1 = y[0] - q1, c2 = y[2] + q3, c3 = y[2] - q3, g0 = y[4] + q5, g1 = y[4] - q5, g2 = y[6] + q7, g3 = y[6] - q7;
            const cf2 r2 = cmulc(c2, w2), r3 = rot_pi(cmulc(c3, w2)), h2 = cmulc(g2, w2), h3 = rot_pi(cmulc(g3, w2));
            const cf2 a0 = c0 + r2, a2 = c0 - r2, a1 = c1 + r3, a3 = c1 - r3, b0 = g0 + h2, b2 = g0 - h2, b1 = g1 + h3, b3 = g1 - h3;
            const cf2 v0 = cmulc(b0, w1), v1 = cmulc(b1, w1), v2 = cmulc(b2, w1), v3 = cmulc(b3, w1);
            const cf2 u0 = v0, u1 = mk2((v1.x - v1.y) * c, (v1.x + v1.y) * c), u2 = rot_pi(v2), u3 = mk2((-v3.x - v3.y) * c, (v3.x - v3.y) * c);
            S[SW(i0)] = a0 + u0; S[SW(i0 + e)] = a1 + u1; S[SW(i0 + 2 * e)] = a2 + u2; S[SW(i0 + 3 * e)] = a3 + u3;
            if (!LOW) { S[SW(i0 + 4 * e)] = a0 - u0; S[SW(i0 + 5 * e)] = a1 - u1; S[SW(i0 + 6 * e)] = a2 - u2; S[SW(i0 + 7 * e)] = a3 - u3; }
        }
    } else {
#pragma unroll 1
        for (int hh = 0; hh < 2; ++hh) {
            cf2 kv[4][4];
            if (KM) {
#pragma unroll
                for (int k = 0; k < 4; ++k) { const int i0 = 4 * (tid + 512 * (hh * 4 + k));
#pragma unroll
                    for (int j = 0; j < 4; ++j) kv[k][j] = Kp[i0 + j]; } }
#pragma unroll
            for (int k = 0; k < 4; ++k) {
                const int i0 = 4 * (tid + 512 * (hh * 4 + k));
                cf2 y0 = S[SW(i0)], y1 = S[SW(i0 + 1)], y2 = S[SW(i0 + 2)], y3 = S[SW(i0 + 3)];
                if (KM) { y0 = cmul(y0, kv[k][0]); y1 = cmul(y1, kv[k][1]); y2 = cmul(y2, kv[k][2]); y3 = cmul(y3, kv[k][3]); }
                const cf2 t0 = y0 + y1, t1 = y0 - y1, t2 = y2 + y3, t3 = rot_pi(y2 - y3);
                S[SW(i0)] = t0 + t2; S[SW(i0 + 2)] = t0 - t2; S[SW(i0 + 1)] = t1 + t3; S[SW(i0 + 3)] = t1 - t3;
            }
        }
    }
}
__device__ __forceinline__ void fft_fwd_pass(LAS cf2* S, int pass) { fft_fwd_pass_t<false>(S, pass); }
__device__ __forceinline__ void fft_inv_pass(LAS cf2* S, int pass) { fft_inv_pass_t<false, false>(S, pass, nullptr); }
#ifndef FFT_HOST
__device__ __forceinline__ void fft_fwd(LAS cf2* S) {
#pragma unroll 1
    for (int p = 0; p < 5; ++p) { fft_fwd_pass_t<false>(S, p); __syncthreads(); }
}
__device__ __forceinline__ void fft_inv(LAS cf2* S) {
#pragma unroll 1
    for (int p = 4; p >= 0; --p) { fft_inv_pass_t<false, false>(S, p, nullptr); __syncthreads(); }
}
__device__ __forceinline__ void fft_fwd_zh(LAS cf2* S) {
    fft_fwd_pass_t<true>(S, 0); __syncthreads();
#pragma unroll 1
    for (int p = 1; p < 5; ++p) { fft_fwd_pass_t<false>(S, p); __syncthreads(); }
}
__device__ __forceinline__ void fft_inv_km(LAS cf2* S, const cf2* Kp) {
    fft_inv_pass_t<false, true>(S, 4, Kp); __syncthreads();
#pragma unroll 1
    for (int p = 3; p >= 1; --p) { fft_inv_pass_t<false, false>(S, p, nullptr); __syncthreads(); }
    fft_inv_pass_t<true, false>(S, 0, nullptr); __syncthreads();
}
#endif
__device__ __forceinline__ float block_sum(float v, LAS float* red) {
    v = wave_sum(v);
    __syncthreads();
    if ((tidx() & 63) == 0) red[tidx() >> 6] = v;
    __syncthreads();
    float s = 0.f;
#pragma unroll
    for (int w = 0; w < 8; ++w) s += red[w];
    return s;
}
__device__ __forceinline__ float hy_delta(int c) { const float mn = -3.0701134573253946f, mx = -15.350567286626973f; return fabsf(mn + (float)c * ((mx - mn) / 1023.0f)); }
__device__ __forceinline__ void hyena_phase(PP P, int io, bool with_ctx, LAS unsigned char* ldsb) {
    const int tid = tidx();
    LAS cf2* S = (LAS cf2*)ldsb; LAS float* ex = (LAS float*)(ldsb + 131072); LAS float* fwc = ex; LAS float* red = ex + 256;
    char* big = P->ws + OFF_BIG;
    const bf16_t* PT = (const bf16_t*)(big + B_PT); bf16_t* ZT = (bf16_t*)(big + B_ZT);
    cf2* KS = (cf2*)(big + B_KS) + (size_t)bidx() * (2 * FN + 8192);
    const bf16_t* hdnb = (const bf16_t*)(P->ws + OFF_HDNB) + (size_t)io * 8192 * 64; const float* hdnc = (const float*)(P->ws + OFF_HDNC);
    const float* fw4 = P->in[I_OFW4] + (size_t)io * 64 * 4096;
    const float* cw = P->in[I_OCW] + (size_t)io * 3 * 3072; const float* cb = P->in[I_OCB] + (size_t)io * 3072; const float* bias = P->in[I_OBIAS] + (size_t)io * 2 * 1024;
    for (int c = bidx(); c < 1024; c += gridDim.x) {
        __syncthreads();
        if (tid < 256) { const int q = tid >> 6, k = tid & 63; fwc[k * 4 + q] = fw4[(size_t)k * 4096 + (q >> 1) * 2048 + (q & 1) * 1024 + c]; }
        __syncthreads();
        const float delta = hy_delta(c);
        float ss0, ss1;
        { const int lane = tid & 63, wave = tid >> 6, kq = lane >> 4, l15 = lane & 15;
          bf16x8 bfr[2];
#pragma unroll
          for (int kb = 0; kb < 2; ++kb) { bf16x8 f;
#pragma unroll
              for (int j = 0; j < 8; ++j) f[j] = (short)(l15 < 4 ? f2bf(fwc[(kb * 32 + kq * 8 + j) * 4 + l15]) : 0);
              bfr[kb] = f; }
          LAS float* Sf = (LAS float*)S; float ssq = 0.f;
          const int n = l15, so = n >> 1;
#pragma unroll 4
          for (int it = 0; it < 64; ++it) { const int tb = (wave + 8 * it) * 16;
              const bf16_t* hp = hdnb + (size_t)(tb + l15) * 64 + kq * 8;
              const bf16x8 a0 = *(const bf16x8*)(hp), a1 = *(const bf16x8*)(hp + 32);
              f32x4 acc = {0.f, 0.f, 0.f, 0.f};
              acc = __builtin_amdgcn_mfma_f32_16x16x32_bf16(a0, bfr[0], acc, 0, 0, 0);
              acc = __builtin_amdgcn_mfma_f32_16x16x32_bf16(a1, bfr[1], acc, 0, 0, 0);
              if (n < 4) {
#pragma unroll
                  for (int r = 0; r < 4; ++r) { const int t = tb + kq * 4 + r; const float f = acc[r] * __expf(-((float)t * (1.0f / 8191.0f)) * delta);
                      if ((n & 1) == 0) { Sf[2 * SW(t) + so] = f; ssq += f * f; }
                      else if (t >= 1) { Sf[2 * SW(FN - t) + so] = f; ssq += f * f; } } }
          }
          if (tid == 0) S[SW(8192)] = mk2(0.f, 0.f);
          ss0 = block_sum(n < 2 ? ssq : 0.f, red); ss1 = block_sum((n == 2 || n == 3) ? ssq : 0.f, red);
        }
        const float sc0 = rsqrtf(ss0 + 1e-6f) * (1.0f / FN), sc1 = rsqrtf(ss1 + 1e-6f) * (1.0f / FN);
        __syncthreads();
#ifdef FFT_REP
#pragma unroll 1
        for (int rep = 0; rep < FFT_REP; ++rep) { fft_fwd(S); fft_inv(S);
#pragma unroll 4
            for (int k = 0; k < 32; ++k) { const int j = tid + 512 * k; S[SW(j)] = S[SW(j)] * (1.0f / 16384.0f); }
            __syncthreads(); }
#endif
        fft_fwd(S);
#pragma unroll 1
        for (int k = 0; k < 32; ++k) { const int j = tid + 512 * k; const int kf = (int)(__brev((unsigned)j) >> 18); const int jp = (int)(__brev((unsigned)((FN - kf) & (FN - 1))) >> 18);
            const cf2 F = S[SW(j)], Fp = S[SW(jp)];
            KS[j] = mk2(0.5f * (F.x + Fp.x) * sc0, 0.5f * (F.y - Fp.y) * sc0);
            KS[FN + j] = mk2(0.5f * (F.y + Fp.y) * sc1, -0.5f * (F.x - Fp.x) * sc1); }
        __syncthreads();
        const float w00 = cw[c], w01 = cw[3072 + c], w02 = cw[6144 + c], b0 = cb[c];
        const float w10 = cw[1024 + c], w11 = cw[3072 + 1024 + c], w12 = cw[6144 + 1024 + c], b1 = cb[1024 + c];
        const float w20 = cw[2048 + c], w21 = cw[3072 + 2048 + c], w22 = cw[6144 + 2048 + c], b2 = cb[2048 + c];
        const float bs0 = bias[c], bs1 = bias[1024 + c];
        auto sconv = [&](const bf16_t* rowp, int t, int L, float wa, float wb, float wc, float bb) -> float {
            const float pm = t > 0 ? bf2f(rowp[t - 1]) : 0.f, pc = bf2f(rowp[t]), pp = t < L - 1 ? bf2f(rowp[t + 1]) : 0.f;
            return wa * pm + wb * pc + wc * pp + bb; };
        struct Ld8 { u32x4 v; float pm, pp; };
        auto ld8 = [&](const bf16_t* rowp, int t0) -> Ld8 { Ld8 r; r.v = *(const u32x4*)(rowp + t0);
            r.pm = t0 > 0 ? bf2f(rowp[t0 - 1]) : 0.f; r.pp = (t0 + 8 < SEQ) ? bf2f(rowp[t0 + 8]) : 0.f; return r; };
        auto sc8 = [&](const Ld8& L, float wa, float wb, float wc, float bb, float (&o)[8]) {
            const float x[10] = {L.pm, lo16(L.v.x), hi16(L.v.x), lo16(L.v.y), hi16(L.v.y), lo16(L.v.z), hi16(L.v.z), lo16(L.v.w), hi16(L.v.w), L.pp};
#pragma unroll
            for (int e = 0; e < 8; ++e) o[e] = wa * x[e] + wb * x[e + 1] + wc * x[e + 2] + bb; };
        auto kmul = [&](const cf2* Kp) {
#pragma unroll 1
            for (int hh = 0; hh < 2; ++hh) {
                u32x4 kv[8];
#pragma unroll
                for (int k = 0; k < 8; ++k) kv[k] = *(const u32x4*)(Kp + 2 * (tid + 512 * (hh * 8 + k)));
#pragma unroll
                for (int k = 0; k < 8; ++k) { LAS f32x4* sp = (LAS f32x4*)(S + SW(2 * (tid + 512 * (hh * 8 + k)))); const f32x4 sv = *sp;
                    const float k0x = __uint_as_float(kv[k].x), k0y = __uint_as_float(kv[k].y), k1x = __uint_as_float(kv[k].z), k1y = __uint_as_float(kv[k].w);
                    *sp = (f32x4){sv[0] * k0x - sv[1] * k0y, sv[0] * k0y + sv[1] * k0x, sv[2] * k1x - sv[3] * k1y, sv[2] * k1y + sv[3] * k1x}; } } };
#pragma unroll 1
        for (int pair = 0; pair < 2; ++pair) {
            const bf16_t* p0a = PT + (size_t)c * TT + (size_t)(2 * pair) * SEQ; const bf16_t* p0b = p0a + SEQ;
            const bf16_t* p1a = p0a + (size_t)1024 * TT; const bf16_t* p1b = p1a + SEQ; const bf16_t* p2a = p0a + (size_t)2048 * TT; const bf16_t* p2b = p2a + SEQ;
            cf2* Z1 = KS + 2 * FN;
            { Ld8 la[2], lb[2];
#pragma unroll
              for (int h = 0; h < 2; ++h) { const int t0 = 8 * (tid + 512 * h); la[h] = ld8(p0a, t0); lb[h] = ld8(p0b, t0); }
#pragma unroll
              for (int h = 0; h < 2; ++h) { const int t0 = 8 * (tid + 512 * h); float za[8], zb[8];
                  sc8(la[h], w00, w01, w02, b0, za); sc8(lb[h], w00, w01, w02, b0, zb);
#pragma unroll
                  for (int e = 0; e < 4; ++e) { *(LAS f32x4*)(S + SW(t0 + 2 * e)) = (f32x4){za[2 * e], zb[2 * e], za[2 * e + 1], zb[2 * e + 1]}; } } }
            __syncthreads();
            fft_fwd_zh(S);
            fft_inv_km(S, KS);
            { Ld8 la[2], lb[2], ga[2], gb[2];
#pragma unroll
              for (int h = 0; h < 2; ++h) { const int t0 = 8 * (tid + 512 * h); la[h] = ld8(p0a, t0); lb[h] = ld8(p0b, t0); ga[h] = ld8(p1a, t0); gb[h] = ld8(p1b, t0); }
#pragma unroll
              for (int h = 0; h < 2; ++h) { const int t0 = 8 * (tid + 512 * h); float za[8], zb[8], g1a[8], g1b[8];
                  sc8(la[h], w00, w01, w02, b0, za); sc8(lb[h], w00, w01, w02, b0, zb); sc8(ga[h], w10, w11, w12, b1, g1a); sc8(gb[h], w10, w11, w12, b1, g1b);
#pragma unroll
                  for (int e = 0; e < 4; ++e) { const f32x4 cv = *(const LAS f32x4*)(S + SW(t0 + 2 * e));
                      const f32x4 z = {g1a[2 * e] * (cv[0] + bs0 * za[2 * e]), g1b[2 * e] * (cv[1] + bs0 * zb[2 * e]),
                                       g1a[2 * e + 1] * (cv[2] + bs0 * za[2 * e + 1]), g1b[2 * e + 1] * (cv[3] + bs0 * zb[2 * e + 1])};
                      *(f32x4*)(Z1 + t0 + 2 * e) = z; *(LAS f32x4*)(S + SW(t0 + 2 * e)) = z; } } }
            __syncthreads();
            fft_fwd_zh(S);
            fft_inv_km(S, KS + FN);
            bf16_t* za_o = ZT + (size_t)c * TT + (size_t)(2 * pair) * SEQ; bf16_t* zb_o = za_o + SEQ;
            { Ld8 ga[2], gb[2]; f32x4 zz[2][4];
#pragma unroll
              for (int h = 0; h < 2; ++h) { const int t0 = 8 * (tid + 512 * h); ga[h] = ld8(p2a, t0); gb[h] = ld8(p2b, t0);
#pragma unroll
                  for (int e = 0; e < 4; ++e) zz[h][e] = *(const f32x4*)(Z1 + t0 + 2 * e); }
#pragma unroll
              for (int h = 0; h < 2; ++h) { const int t0 = 8 * (tid + 512 * h); float g2a[8], g2b[8], oa[8], ob[8];
                  sc8(ga[h], w20, w21, w22, b2, g2a); sc8(gb[h], w20, w21, w22, b2, g2b);
#pragma unroll
                  for (int e = 0; e < 4; ++e) { const f32x4 cv = *(const LAS f32x4*)(S + SW(t0 + 2 * e)); const f32x4 z1 = zz[h][e];
                      oa[2 * e] = g2a[2 * e] * (cv[0] + bs1 * z1[0]); ob[2 * e] = g2b[2 * e] * (cv[1] + bs1 * z1[1]);
                      oa[2 * e + 1] = g2a[2 * e + 1] * (cv[2] + bs1 * z1[2]); ob[2 * e + 1] = g2b[2 * e + 1] * (cv[3] + bs1 * z1[3]); }
                  u32x4 wa_, wb_; wa_.x = pk2(oa[0], oa[1]); wa_.y = pk2(oa[2], oa[3]); wa_.z = pk2(oa[4], oa[5]); wa_.w = pk2(oa[6], oa[7]);
                  wb_.x = pk2(ob[0], ob[1]); wb_.y = pk2(ob[2], ob[3]); wb_.z = pk2(ob[4], ob[5]); wb_.w = pk2(ob[6], ob[7]);
                  *(u32x4*)(za_o + t0) = wa_; *(u32x4*)(zb_o + t0) = wb_; } }
            __syncthreads();
        }
        if (with_ctx) {
            LAS float* kl = (LAS float*)ldsb;
            LAS float* zc = kl + 1024;
            float s0 = 0.f, s1 = 0.f; float f0 = 0.f, f1 = 0.f, f2 = 0.f, f3 = 0.f;
            if (tid < 256) { const int t = tid; const float* hr = hdnc + (size_t)t * 64;
                for (int k = 0; k < 64; ++k) { const float hv = hr[k]; f0 += hv * fwc[4 * k]; f1 += hv * fwc[4 * k + 1]; f2 += hv * fwc[4 * k + 2]; f3 += hv * fwc[4 * k + 3]; }
                const float dec = expf(-((float)t / 255.0f) * delta); f0 *= dec; f1 *= dec; f2 *= dec; f3 *= dec;
                s0 = f0 * f0 + (t >= 1 ? f1 * f1 : 0.f); s1 = f2 * f2 + (t >= 1 ? f3 * f3 : 0.f); }
            const float c0s = rsqrtf(block_sum(s0, red) + 1e-6f), c1s = rsqrtf(block_sum(s1, red) + 1e-6f);
            if (tid < 256) { const int t = tid; kl[256 + t] = f0 * c0s; kl[512 + 256 + t] = f2 * c1s; if (t >= 1) { kl[256 - t] = f1 * c0s; kl[512 + 256 - t] = f3 * c1s; } }
            float zv[2], gv1[2], gv2[2];
#pragma unroll
            for (int e = 0; e < 2; ++e) { const int idx = tid + 512 * e, bb = idx >> 8, t = idx & 255;
                const bf16_t* rp = PT + (size_t)c * TT + TLAT + bb * CTXL;
                zv[e] = sconv(rp, t, CTXL, w00, w01, w02, b0); gv1[e] = sconv(rp + (size_t)1024 * TT, t, CTXL, w10, w11, w12, b1); gv2[e] = sconv(rp + (size_t)2048 * TT, t, CTXL, w20, w21, w22, b2);
                zc[idx] = zv[e]; }
            __syncthreads();
#pragma unroll 1
            for (int n = 0; n < 2; ++n) {
                float cvv[2];
#pragma unroll
                for (int e = 0; e < 2; ++e) { const int idx = tid + 512 * e, bb = idx >> 8, t = idx & 255; float a = 0.f;
                    for (int s = 0; s < 256; ++s) a += zc[bb * 256 + s] * kl[n * 512 + 256 + t - s];
                    cvv[e] = a; }
                __syncthreads();
#pragma unroll
                for (int e = 0; e < 2; ++e) { const int idx = tid + 512 * e;
                    zv[e] = (n == 0 ? gv1[e] : gv2[e]) * (cvv[e] + (n == 0 ? bs0 : bs1) * zv[e]); zc[idx] = zv[e]; }
                __syncthreads();
            }
#pragma unroll
            for (int e = 0; e < 2; ++e) { const int idx = tid + 512 * e; ZT[(size_t)c * TT + TLAT + idx] = f2bf(zv[e]); }
            __syncthreads();
        }
    }
}
__device__ __forceinline__ void tr_phase(PP P, int ntok, LAS unsigned char* ldsb) {
    const int tid = tidx(); LAS bf16_t* tile = (LAS bf16_t*)ldsb;
    const bf16_t* ZT = (const bf16_t*)(P->ws + OFF_BIG + B_ZT); bf16_t* A2 = (bf16_t*)(P->ws + OFF_H);
    const int ntt = ntok / 256;
    for (int it = bidx(); it < 16 * ntt; it += gridDim.x) {
        const int ct = it & 15, tt = it >> 4, c0 = ct * 64, t0 = tt * 256;
        u32x4 v[4];
        { const int ch = tid >> 3, ck = tid & 7;
#pragma unroll
          for (int q = 0; q < 4; ++q) v[q] = *(const u32x4*)(ZT + (size_t)(c0 + ch) * TT + t0 + q * 64 + ck * 8);
#pragma unroll
          for (int q = 0; q < 4; ++q) *(LAS u32x4*)(tile + q * (64 * 72) + ch * 72 + ck * 8) = v[q]; }
        __syncthreads();
        { const int tk = tid >> 3, ck = tid & 7;
#pragma unroll
          for (int q = 0; q < 4; ++q) { unsigned short e[8];
#pragma unroll
              for (int j = 0; j < 8; ++j) e[j] = tile[q * (64 * 72) + (ck * 8 + j) * 72 + tk];
              u32x4 w; w.x = e[0] | ((unsigned)e[1] << 16); w.y = e[2] | ((unsigned)e[3] << 16); w.z = e[4] | ((unsigned)e[5] << 16); w.w = e[6] | ((unsigned)e[7] << 16);
              *(u32x4*)(A2 + (size_t)(t0 + q * 64 + tk) * 1024 + c0 + ck * 8) = w; } }
        __syncthreads();
    }
}
__device__ __forceinline__ void final_phase(PP P) {
    const int lane = tidx() & 63, gw = bidx() * 8 + (tidx() >> 6), NGW = gridDim.x * 8;
    const float* gain = P->in[I_FINALG];
    for (int row0 = gw; row0 < TLAT; row0 += 4 * NGW) {
        f32x4 v[4][4];
#pragma unroll
        for (int q = 0; q < 4; ++q) { const int row = row0 + q * NGW;
            if (row < TLAT) {
#pragma unroll
                for (int j = 0; j < 4; ++j) v[q][j] = *(const f32x4*)(P->out + (size_t)row * D + 4 * lane + 256 * j); } }
#pragma unroll
        for (int q = 0; q < 4; ++q) { const int row = row0 + q * NGW; if (row >= TLAT) continue;
            float s = 0.f;
#pragma unroll
            for (int j = 0; j < 4; ++j) s += (v[q][j][0] * v[q][j][0] + v[q][j][1] * v[q][j][1]) + (v[q][j][2] * v[q][j][2] + v[q][j][3] * v[q][j][3]);
            const float rstd = rsqrtf(wave_sum(s) * (1.f / D) + 1e-6f);
#pragma unroll
            for (int j = 0; j < 4; ++j) { const int c = 4 * lane + 256 * j; *(f32x4*)(P->out + (size_t)row * D + c) = v[q][j] * rstd * *(const f32x4*)(gain + c); } }
    }
}
#ifndef DUP_MASK
#define DUP_MASK 0u
#endif
#ifndef NOP_COUNT
#define NOP_COUNT 0
#endif
#ifndef PHASE_MASK
#define PHASE_MASK 0xFFFFFFFFu
#endif
#define EN(t) if (!((PHASE_MASK >> (t)) & 1u)) break;
__global__ void __launch_bounds__(512, 2) mega(const Params Pv, int p0, int p1) {
    PP P = (PP)__builtin_amdgcn_kernarg_segment_ptr();
    extern __shared__ __attribute__((aligned(16))) unsigned char dyn_lds[];
    LAS unsigned char* lds = (LAS unsigned char*)dyn_lds;
    cg::grid_group grid = cg::this_grid();
    volatile LAS unsigned* xst = (volatile LAS unsigned*)(lds + LDS_BYTES - 16);
    if (threadIdx.x == 0) { xst[0] = 0u; xst[1] = 0u; }
    __syncthreads();
    XcdBarrier xb = xcd_barrier_post((unsigned*)Pv.ws, xst);
    for (int ip = p0; ip < p1; ++ip) {
        asm volatile("" : "+s"(P) : "s"(ip));
    char* ws = P->ws;
        float* XC = (float*)(ws + OFF_XC); const float* mods = (const float*)(ws + OFF_MODS);
        bf16_t* H = (bf16_t*)(ws + OFF_H); bf16_t* ACT = (bf16_t*)(ws + OFF_BIG);
        bf16_t* W1 = (bf16_t*)(ws + OFF_W1); bf16_t* W2 = (bf16_t*)(ws + OFF_W2); char* WM = ws + OFF_WMIX; char* big = ws + OFF_BIG;
        Phase ph; ph.type = P->ph[ip].type; ph.l = P->ph[ip].l; ph.a = P->ph[ip].a; ph.b = P->ph[ip].b & 0xff; const int nkpend = (P->ph[ip].b >> 12) & 0xff; float* PART = (float*)(big + (size_t)200 * 1024 * 1024); const bool dry = (P->ph[ip].b & 0x100) != 0; const int l = ph.l, i = l >> 1;
        float* dry_out = (float*)(big + (ph.type == PH_F2 ? (size_t)200 * 1024 * 1024 : 0));
        const float* mods_l = mods + (size_t)l * 5 * 9216;
        const bool first = (l == 0 && ph.b == 0);
        const float* in_lat = first ? P->in[I_X] : P->out; const float* in_ctx = first ? P->in[I_CTX] : XC;
        switch (ph.type) {
        case PH_PREP_A: EN(PH_PREP_A) prep_a(P, (LAS float*)lds); break;
        case PH_PREP_B: EN(PH_PREP_B) prep_b(P); break;
        case PH_CONV_NORM: EN(PH_CONV_NORM)
            conv_weights(P, l, (LAS float*)lds);
            norm_rows(in_lat, in_ctx, ph.a, P->in[I_NORMG] + (size_t)(l * 3 + 0) * 1024, mods_l, 0, 1, H, PART, nkpend, XC); break;
        case PH_NORM: EN(PH_NORM) { const int j = ph.b;
            norm_rows(P->out, XC, ph.a, P->in[I_NORMG] + (size_t)(l * 3 + j) * 1024, mods_l, j == 1 ? 3 : 6, j == 1 ? 4 : 7, H, PART, nkpend, XC); } break;
        case PH_F1: EN(PH_F1) { EpiSwiglu E; E.O = ACT; run_gemm(lds, H, W1 + (size_t)ph.b * 5632 * 1024, ph.a, 5632, 1024, E); } break;
        case PH_F2: EN(PH_F2) { EpiResid E; E.in_lat = in_lat; E.in_ctx = in_ctx; E.out_lat = dry ? dry_out : P->out; E.out_ctx = dry ? dry_out + (size_t)TLAT * D : XC; E.gate = mods_l + (ph.b == 0 ? 2 : 8) * 1024; E.scale = 0.5f;
            run_gemm(lds, ACT, W2 + (size_t)ph.b * 1024 * DFF, TLAT, 1024, DFF, E);
            if (ph.a > TLAT) ctx_splitk(lds, ACT + (size_t)TLAT * DFF, W2 + (size_t)ph.b * 1024 * DFF, DFF, PART, mods_l + (size_t)4 * 9216 + (ph.b == 0 ? 2 : 8) * 1024, 0.5f); } break;
        case PH_E1: EN(PH_E1) { EpiBf16Out E; E.O0 = (bf16_t*)(big + B_U); E.ld0 = 512; E.nt0 = 2; E.O1 = (bf16_t*)(big + B_PR); E.ld1 = 2048;
            run_gemm(lds, H, (const bf16_t*)(WM + WM_EWIN), TT, 2560, 1024, E); } break;
        case PH_FEAT: EN(PH_FEAT) feat_phase(P, i); break;
        case PH_E3: EN(PH_E3) { EpiLora E; E.EA = (bf16_t*)(big + B_PR); E.G = (bf16_t*)(big + B_G); E.w0 = P->in[I_EW0] + (size_t)i * 1024; E.a0 = P->in[I_EA0] + (size_t)i * 1024;
            E.pn_off = 0; run_gemm(lds, (const bf16_t*)(big + B_LORA), (const bf16_t*)(WM + WM_ELORA), TT, 2560, 384, E); } break;
        case PH_SCAN: EN(PH_SCAN) scan_phase(P, i, lds); break;
        case PH_READ: EN(PH_READ) read_phase(P, i, ph.a); break;
        case PH_GLU: EN(PH_GLU) { EpiGlu E; E.YG = (const bf16_t*)(big + B_YS); E.YCAT = H; E.bglu = P->in[I_EBGLU] + (size_t)i * 512;
            run_gemm(lds, (const bf16_t*)(big + B_YS), (const bf16_t*)(WM + WM_EGLU), ph.a, 512, 512, E); } break;
        case PH_EOUT: EN(PH_EOUT) { EpiResid E; E.in_lat = P->out; E.in_ctx = XC; E.out_lat = dry ? dry_out : P->out; E.out_ctx = dry ? dry_out + (size_t)TLAT * D : XC; E.gate = mods_l + 5 * 1024; E.scale = 1.0f;
            run_gemm(lds, H, (const bf16_t*)(WM + WM_EOUT), TLAT, 1024, 1024, E);
            if (ph.a > TLAT) ctx_splitk(lds, H + (size_t)TLAT * D, (const bf16_t*)(WM + WM_EOUT), 1024, PART, mods_l + (size_t)4 * 9216 + 5 * 1024, 1.0f); } break;
        case PH_O1: EN(PH_O1) { EpiBf16Out E; E.O0 = (bf16_t*)(big + B_PT); E.ld0 = TT; E.nt0 = 1 << 20; E.O1 = E.O0; E.ld1 = TT;
            run_gemm(lds, (const bf16_t*)(WM + WM_OWIN), H, 3072, ph.a, 1024, E, WGM_SWAPPED); } break;
        case PH_HY: EN(PH_HY) hyena_phase(P, i, ph.a > TLAT, lds); break;
        case PH_TR: EN(PH_TR) tr_phase(P, ph.a, lds); break;
        case PH_OOUT: EN(PH_OOUT) { EpiResid E; E.in_lat = P->out; E.in_ctx = XC; E.out_lat = dry ? dry_out : P->out; E.out_ctx = dry ? dry_out + (size_t)TLAT * D : XC; E.gate = mods_l + 5 * 1024; E.scale = 1.0f;
            run_gemm(lds, H, (const bf16_t*)(WM + WM_OOUT), TLAT, 1024, 1024, E);
            if (ph.a > TLAT) ctx_splitk(lds, H + (size_t)TLAT * D, (const bf16_t*)(WM + WM_OOUT), 1024, PART, mods_l + (size_t)4 * 9216 + 5 * 1024, 1.0f); } break;
        case PH_FINAL: EN(PH_FINAL) final_phase(P); break;
        default: break;
        }
        if (ip + 1 < p1) { if (p1 < 0) grid.sync(); else xcd_barrier(xb); }
    }
}

#ifndef MULTI_LAUNCH
#define MULTI_LAUNCH 0
#endif
extern "C" void kernel_launch(void* const* d_in, const int* in_sizes, int n_in, void* d_out, int out_size, void* d_ws, size_t ws_size, hipStream_t stream) {
    static int grid = 0;
    if (grid == 0) {
        if (n_in != N_IN || ws_size < WS_END) { fprintf(stderr, "kernel_launch: unexpected n_in %d / ws_size %zu (need %zu)\n", n_in, ws_size, (size_t)WS_END); grid = -1; return; }
        if (hipFuncSetAttribute((const void*)mega, hipFuncAttributeMaxDynamicSharedMemorySize, LDS_BYTES) != hipSuccess) { fprintf(stderr, "hipFuncSetAttribute failed\n"); grid = -1; return; }
        int dev = 0, cus = 0, per_cu = 0;
        hipGetDevice(&dev); hipDeviceGetAttribute(&cus, hipDeviceAttributeMultiprocessorCount, dev);
        hipOccupancyMaxActiveBlocksPerMultiprocessor(&per_cu, (const void*)mega, NTHREADS, LDS_BYTES);
        (void)hipGetLastError();
        if (per_cu < 1) per_cu = 1;
        grid = cus > 256 ? 256 : cus;
    }
    if (grid < 0) return;
    Params P; memset(&P, 0, sizeof(P));
    for (int k = 0; k < N_IN; ++k) P.in[k] = (const float*)d_in[k];
    P.out = (float*)d_out; P.ws = (char*)d_ws;
    int n = 0;
    auto add1 = [&](int type, int l, int a, int b) { P.ph[n].type = type; P.ph[n].l = l; P.ph[n].a = a; P.ph[n].b = b; ++n; };
    auto add = [&](int type, int l, int a, int b) { if ((DUP_MASK >> type) & 1u) add1(type, l, a, b | 0x100); add1(type, l, a, b); };
    add(PH_PREP_A, 0, 0, 0); add(PH_PREP_B, 0, 0, 1);
    int pend = 0;
    for (int l = 0; l < 4; ++l) {
        const int ra = l <= 2 ? TT : TLAT, ro = l < 2 ? TT : TLAT;
        add(PH_CONV_NORM, l, ra, 0 | (pend << 12)); pend = 0;
        add(PH_F1, l, ra, 0); add(PH_F2, l, ra, 0); if (ra > TLAT) pend = 11;
        add(PH_NORM, l, ra, 1 | (pend << 12)); pend = 0;
        if ((l & 1) == 0) { add(PH_E1, l, TT, 1); add(PH_FEAT, l, TT, 1); add(PH_E3, l, TT, 1); add(PH_SCAN, l, TT, 1); add(PH_READ, l, ro, 1); add(PH_GLU, l, ro, 1); add(PH_EOUT, l, ro, 1); }
        else { add(PH_O1, l, ro, 1); add(PH_HY, l, ro, 1); add(PH_TR, l, ro, 1); add(PH_OOUT, l, ro, 1); }
        if (ro > TLAT) pend = 4;
        add(PH_NORM, l, ro, 2 | (pend << 12)); pend = 0;
        add(PH_F1, l, ro, 1); add(PH_F2, l, ro, 1); if (ro > TLAT) pend = 11;
    }
    for (int k = 0; k < NOP_COUNT; ++k) add1(99, 0, 0, 1);
    add(PH_FINAL, 4, 0, 1);
    P.nph = n;
#if MULTI_LAUNCH
    for (int k = 0; k < n; ++k) { hipLaunchKernelGGL(mega, dim3(grid), dim3(NTHREADS), LDS_BYTES, stream, P, k, k + 1); }
#else
    (void)hipMemsetAsync(d_ws, 0, 16384, stream);
    int p0 = 0, p1 = n; void* args[] = {(void*)&P, (void*)&p0, (void*)&p1};
    hipError_t e = hipLaunchCooperativeKernel((const void*)mega, dim3(grid), dim3(NTHREADS), args, LDS_BYTES, stream);
    if (e != hipSuccess) fprintf(stderr, "cooperative launch failed: %s (grid %d)\n", hipGetErrorString(e), grid);
#endif
}
```

```cpp
#include <hip/hip_runtime.h>
#include <hip/hip_cooperative_groups.h>
#include <cstdio>
#include <cstdint>
#include <cstring>
namespace cg = cooperative_groups;
__device__ __forceinline__ int tidx() { int t = threadIdx.x; asm volatile("" : "+v"(t)); return t; }
__device__ __forceinline__ int bidx() { int t = blockIdx.x; asm volatile("" : "+s"(t)); return t; }
#define LAS __attribute__((address_space(3)))
#ifndef PG8_WGM
#define PG8_WGM 8
#endif
namespace pg8 {
#define PG8_LAS __attribute__((address_space(3)))
typedef unsigned short bf16_t;
typedef short bf16x8 __attribute__((ext_vector_type(8)));
typedef float f32x4 __attribute__((ext_vector_type(4)));
typedef unsigned u32x4 __attribute__((ext_vector_type(4)));
constexpr int BM = 256, BK = 64, HALF = 128, HTB = HALF * BK * 2  , STAGE_BYTES = 8 * HTB, NXCD = 8, WGM = PG8_WGM;

__host__ __device__ __forceinline__ int lds_byte(int r, int c) { const int st = (r >> 4) * 2 + (c >> 5), rr = r & 15, cc = c & 31, ob = rr * 64 + cc * 2; return st * 1024 + (ob ^ (((ob >> 9) & 1) << 5)); }
__host__ __device__ __forceinline__ void stage_rc(int b, int& R, int& C) { const int st = b / 1024, sb = b % 1024, swz = sb ^ (((sb >> 9) & 1) << 5); R = (st >> 1) * 16 + swz / 64; C = (st & 1) * 32 + (swz % 64) / 2; }
__host__ __device__ __forceinline__ int perm32(int rho) { const int n = rho >> 4, i = rho & 15; return 8 * (i >> 2) + 4 * n + (i & 3); }

struct Unit { int pm, pn; };
struct Gemm { const bf16_t* A; const bf16_t* Bt; int M, N, K; int Kloop; };

struct StaticOrder {
    int nM, nN, nwg, G, c, wgm = WGM;
    __host__ __device__ void init(int M, int N, int G_, int c_) { nM = M / BM; nN = N / BM; nwg = nM * nN; G = G_; c = c_; }
    __host__ __device__ bool next(int i, Unit& u) const {
        const long L = (long)i * G + c; if (L >= nwg) return false;
        int wgid = (int)L; { const int q = nwg / NXCD, r = nwg % NXCD, xcd = wgid % NXCD, off = wgid / NXCD; wgid = (xcd < r ? xcd * (q + 1) : r * (q + 1) + (xcd - r) * q) + off; }
        const int nig = wgm * nN, gid = wgid / nig, fm = gid * wgm, gsz = (nM - fm) < wgm ? (nM - fm) : wgm;
        u.pm = fm + ((wgid % nig) % gsz); u.pn = (wgid % nig) / gsz; return true;
    }
    __device__ __forceinline__ void a_ready(const Unit&) const {}
    __device__ __forceinline__ void done(const Unit&) const {}
};

__device__ __forceinline__ unsigned cvt_pk_bf16(float lo, float hi) { unsigned r; asm volatile("v_cvt_pk_bf16_f32 %0, %1, %2" : "=v"(r) : "v"(lo), "v"(hi)); return r; }
typedef float f32x2 __attribute__((ext_vector_type(2)));
__device__ __forceinline__ f32x2 gelu_pk(f32x2 v) {
    const f32x2 av = __builtin_elementwise_abs(v), d = av * 0.2316418882f + 1.0f;
    f32x2 t; t.x = __builtin_amdgcn_rcpf(d.x); t.y = __builtin_amdgcn_rcpf(d.y);
    f32x2 q = t * 0.5307027145f + (-0.7265760135f); q = q * t + 0.7107068705f; q = q * t + (-0.142248368f); q = q * t + 0.127414796f; q = q * t;
    const f32x2 s = (v * v) * (-0.72134752044f);
    f32x2 e; e.x = __builtin_amdgcn_exp2f(s.x); e.y = __builtin_amdgcn_exp2f(s.y);
    const f32x2 m = v * (q * e), r = v - m;
    f32x2 o; o.x = v.x < 0.f ? m.x : r.x; o.y = v.y < 0.f ? m.y : r.y; return o;
}

template <class Epi, class Sched, bool ALIGN_EPI = false, bool SP2 = false>
__device__ __forceinline__ void gemm_phase(PG8_LAS unsigned char* lds, const Gemm g, const Sched& S, const Epi& E) {
    const int tid = tidx(), wid = __builtin_amdgcn_readfirstlane(tid >> 6), lane = tid & 63, wr = wid >> 2, wc = wid & 3, fr = lane & 15, fq = lane >> 4;
    const int K = g.K, nt = g.Kloop / BK;
    unsigned voffA[2], voffB[2];
#pragma unroll
    for (int i = 0; i < 2; ++i) { int R, C; stage_rc(tid * 16 + i * 8192, R, C); const int Rb = Epi::PERM ? ((R & ~31) + perm32(R & 31)) : R;
        voffA[i] = (unsigned)(R * K + C) * 2u; voffB[i] = (unsigned)(Rb * K + C) * 2u; }
    const size_t kstep = (size_t)(BK * 2);
    const size_t hstep = (size_t)HALF * K * 2;
    const size_t tstep = 2 * hstep;
    const unsigned ldsw = (unsigned)wid * 1024u;
    const int aoff = lds_byte(wr * 64 + fr, fq * 8), boff = lds_byte(wc * 32 + fr, fq * 8);
#define PG8_SA(b, h) (((b) * 2 + (h)) * HTB)
#define PG8_SB(b, h) ((4 + (b) * 2 + (h)) * HTB)
#define PG8_STAGE(bufoff, gbase, voff) do { _Pragma("unroll") for (int _i = 0; _i < 2; ++_i) \
        __builtin_amdgcn_global_load_lds((const unsigned*)((const char*)(gbase) + (voff)[_i]), (PG8_LAS unsigned*)(lds + (bufoff) + ldsw + _i * 8192), 16, 0, 0); } while (0)
#define PG8_LDA(dst, b, h) do { _Pragma("unroll") for (int m = 0; m < 4; ++m) _Pragma("unroll") for (int k = 0; k < 2; ++k) dst[m][k] = *(const PG8_LAS bf16x8*)(lds + PG8_SA(b, h) + aoff + m * 2048 + k * 1024); } while (0)
#define PG8_LDB(dst, b, h) do { _Pragma("unroll") for (int n = 0; n < 2; ++n) _Pragma("unroll") for (int k = 0; k < 2; ++k) dst[n][k] = *(const PG8_LAS bf16x8*)(lds + PG8_SB(b, h) + boff + n * 2048 + k * 1024); } while (0)
#define PG8_MMA(ai, bj, At, Bt) do { __builtin_amdgcn_s_setprio(1); _Pragma("unroll") for (int m = 0; m < 4; ++m) _Pragma("unroll") for (int n = 0; n < 2; ++n) _Pragma("unroll") for (int k = 0; k < 2; ++k) \
        acc[ai][bj][m][n] = __builtin_amdgcn_mfma_f32_16x16x32_bf16(Bt[n][k], At[m][k], acc[ai][bj][m][n], 0, 0, 0); __builtin_amdgcn_s_setprio(0); } while (0)
#define PG8_WAIT_V(n) asm volatile("s_waitcnt vmcnt(" #n ")" ::: "memory")
#define PG8_WAIT_L(n) asm volatile("s_waitcnt lgkmcnt(" #n ")" ::: "memory")
#define PG8_BAR __builtin_amdgcn_s_barrier()
#define PG8_SCHED __builtin_amdgcn_sched_barrier(0)
    Unit cur, nxt; int ui = 0;
    if (!S.next(0, cur)) return;
    f32x4 acc[2][2][4][2];
#pragma unroll
    for (int a = 0; a < 2; ++a)
#pragma unroll
        for (int b = 0; b < 2; ++b)
#pragma unroll
            for (int m = 0; m < 4; ++m)
#pragma unroll
                for (int n = 0; n < 2; ++n) acc[a][b][m][n] = (f32x4){0.f, 0.f, 0.f, 0.f};
    bf16x8 At[4][2], B0[2][2], B1[2][2];
    const char* cA = (const char*)g.A + (size_t)cur.pm * tstep; const char* cB = (const char*)g.Bt + (size_t)cur.pn * tstep;
    S.a_ready(cur);
    if constexpr (SP2) {
        PG8_STAGE(PG8_SB(0, 0), cB, voffB); PG8_STAGE(PG8_SB(0, 1), cB + hstep, voffB); PG8_STAGE(PG8_SA(0, 0), cA, voffA); PG8_STAGE(PG8_SA(0, 1), cA + hstep, voffA);
        if (wr == 1) PG8_BAR;
        PG8_WAIT_V(2); PG8_BAR;
        PG8_STAGE(PG8_SB(1, 0), cB + kstep, voffB); PG8_STAGE(PG8_SA(1, 0), cA + kstep, voffA); PG8_STAGE(PG8_SB(1, 1), cB + hstep + kstep, voffB);
        PG8_WAIT_V(6); PG8_BAR;
    } else {
        PG8_STAGE(PG8_SB(0, 0), cB, voffB); PG8_STAGE(PG8_SA(0, 0), cA, voffA); PG8_STAGE(PG8_SB(0, 1), cB + hstep, voffB); PG8_STAGE(PG8_SA(0, 1), cA + hstep, voffA);
        if (wr == 1) PG8_BAR;
        PG8_WAIT_V(4); PG8_BAR;
        PG8_STAGE(PG8_SB(1, 0), cB + kstep, voffB); PG8_STAGE(PG8_SA(1, 0), cA + kstep, voffA); PG8_STAGE(PG8_SB(1, 1), cB + hstep + kstep, voffB);
        PG8_WAIT_V(6); PG8_BAR;
    }
    for (;;) {
        const bool has_next = S.next(ui + 1, nxt);
        const char* nA = has_next ? (const char*)g.A + (size_t)nxt.pm * tstep : cA; const char* nB = has_next ? (const char*)g.Bt + (size_t)nxt.pn * tstep : cB;
        for (int t = 0; t < nt; t += 2) {
            const bool last = (t == nt - 2);
            const char* a1 = cA + (size_t)(t + 1) * kstep;
            const char* a2 = last ? nA : cA + (size_t)(t + 2) * kstep; const char* b2 = last ? nB : cB + (size_t)(t + 2) * kstep;
            const char* a3 = a2 + kstep; const char* b3 = b2 + kstep;
            if (last && has_next) S.a_ready(nxt);
            if constexpr (SP2) {
            PG8_LDB(B0, 0, 0); PG8_LDB(B1, 0, 1); PG8_SCHED; PG8_LDA(At, 0, 0); PG8_STAGE(PG8_SA(1, 1), a1 + hstep, voffA);
            PG8_WAIT_V(8); PG8_WAIT_L(0); PG8_BAR; PG8_MMA(0, 0, At, B0); PG8_MMA(0, 1, At, B1); PG8_BAR; PG8_SCHED;
            PG8_LDA(At, 0, 1); PG8_STAGE(PG8_SB(0, 0), b2, voffB); PG8_STAGE(PG8_SB(0, 1), b2 + hstep, voffB); PG8_STAGE(PG8_SA(0, 0), a2, voffA);
            PG8_WAIT_V(8); PG8_WAIT_L(0); PG8_BAR; PG8_MMA(1, 0, At, B0); PG8_MMA(1, 1, At, B1); PG8_BAR; PG8_SCHED;
            PG8_LDB(B0, 1, 0); PG8_LDB(B1, 1, 1); PG8_SCHED; PG8_LDA(At, 1, 0); PG8_STAGE(PG8_SA(0, 1), a2 + hstep, voffA);
            PG8_WAIT_V(8); PG8_WAIT_L(0); PG8_BAR; PG8_MMA(0, 0, At, B0); PG8_MMA(0, 1, At, B1); PG8_BAR; PG8_SCHED;
            PG8_LDA(At, 1, 1); PG8_STAGE(PG8_SB(1, 0), b3, voffB); PG8_STAGE(PG8_SB(1, 1), b3 + hstep, voffB); PG8_STAGE(PG8_SA(1, 0), a3, voffA);
            PG8_WAIT_V(8); PG8_WAIT_L(0); PG8_BAR; PG8_MMA(1, 0, At, B0); PG8_MMA(1, 1, At, B1); PG8_BAR; PG8_SCHED;
            } else {
            PG8_LDB(B0, 0, 0); PG8_SCHED; PG8_LDA(At, 0, 0); PG8_STAGE(PG8_SA(1, 1), a1 + hstep, voffA);
            PG8_WAIT_L(8); PG8_BAR; PG8_WAIT_L(0); PG8_MMA(0, 0, At, B0); PG8_BAR; PG8_SCHED;
            PG8_LDB(B1, 0, 1); PG8_STAGE(PG8_SB(0, 0), b2, voffB);
            PG8_BAR; PG8_WAIT_L(0); PG8_MMA(0, 1, At, B1); PG8_BAR;
            PG8_LDA(At, 0, 1); PG8_STAGE(PG8_SA(0, 0), a2, voffA);
            PG8_BAR; PG8_WAIT_L(0); PG8_MMA(1, 0, At, B0); PG8_BAR; PG8_SCHED;
            PG8_STAGE(PG8_SB(0, 1), b2 + hstep, voffB);
            PG8_WAIT_V(6); PG8_BAR; PG8_MMA(1, 1, At, B1); PG8_BAR;
            PG8_LDB(B0, 1, 0); PG8_SCHED; PG8_LDA(At, 1, 0); PG8_STAGE(PG8_SA(0, 1), a2 + hstep, voffA);
            PG8_WAIT_L(8); PG8_BAR; PG8_WAIT_L(0); PG8_MMA(0, 0, At, B0); PG8_BAR; PG8_SCHED;
            PG8_LDB(B1, 1, 1); PG8_STAGE(PG8_SB(1, 0), b3, voffB);
            PG8_BAR; PG8_WAIT_L(0); PG8_MMA(0, 1, At, B1); PG8_BAR;
            PG8_LDA(At, 1, 1); PG8_STAGE(PG8_SA(1, 0), a3, voffA);
            PG8_BAR; PG8_WAIT_L(0); PG8_MMA(1, 0, At, B0); PG8_BAR; PG8_SCHED;
            PG8_STAGE(PG8_SB(1, 1), b3 + hstep, voffB);
            PG8_WAIT_V(6); PG8_BAR; PG8_MMA(1, 1, At, B1); PG8_BAR;
            }
        }
        if constexpr (ALIGN_EPI) { if (wr == 0) PG8_BAR; }
        if constexpr (!Epi::AFTER_DRAIN) { E(acc, cur, wr, wc, fr, fq); S.done(cur); }
        if (!has_next) break;
#pragma unroll
        for (int a = 0; a < 2; ++a)
#pragma unroll
            for (int b = 0; b < 2; ++b)
#pragma unroll
                for (int m = 0; m < 4; ++m)
#pragma unroll
                    for (int n = 0; n < 2; ++n) acc[a][b][m][n] = (f32x4){0.f, 0.f, 0.f, 0.f};
        cur = nxt; cA = nA; cB = nB; ++ui;
        if constexpr (ALIGN_EPI) { if (wr == 1) PG8_BAR; }
    }
    PG8_WAIT_V(0);
    if constexpr (!ALIGN_EPI) { if (wr == 0) PG8_BAR; }
    PG8_BAR;
    if constexpr (Epi::AFTER_DRAIN) { E.fused(acc, cur, wr, wc, fr, fq, lds, wid, lane); S.done(cur); }
#undef PG8_SA
#undef PG8_SB
#undef PG8_STAGE
#undef PG8_LDA
#undef PG8_LDB
#undef PG8_MMA
#undef PG8_WAIT_V
#undef PG8_WAIT_L
#undef PG8_BAR
#undef PG8_SCHED
}
}
#define XB_TMO      128
#define XB_XCNT(j)  (256  + 64 * (j))
#define XB_XSUB(j)  (1280 + 64 * (j))
#define XB_XGEN(j)  (2304 + 64 * (j))
#define XB_TOP      3328
#define XB_TOPGEN   3392
#define XCD_BAR_WORDS 3456
#define XB_SPIN_CAP (1u << 18)

__device__ __forceinline__ unsigned xb_ld(unsigned* p)              { return __hip_atomic_load(p, __ATOMIC_RELAXED, __HIP_MEMORY_SCOPE_AGENT); }
__device__ __forceinline__ unsigned xb_add(unsigned* p, unsigned v) { return __hip_atomic_fetch_add(p, v, __ATOMIC_RELAXED, __HIP_MEMORY_SCOPE_AGENT); }
__device__ __forceinline__ unsigned xb_xcc_id() { return (unsigned)__builtin_amdgcn_s_getreg((3 << 11) | 20) & 0xFu; }
#define XB_SPIN(cond, bar) do { unsigned _sp = 0; while (cond) { __builtin_amdgcn_s_sleep(1); \
    if ((++_sp & 255u) == 0u) { if (xb_ld(&(bar)[XB_TMO])) break; if (_sp > XB_SPIN_CAP) { atomicAdd(&(bar)[XB_TMO], 1u); break; } } } } while (0)

struct XcdBarrier {
    unsigned* bar; unsigned x;
    volatile LAS unsigned* st;
};

__device__ __forceinline__ XcdBarrier xcd_barrier_post(unsigned* bar, volatile LAS unsigned* st) {
    XcdBarrier b; b.bar = bar; b.x = xb_xcc_id(); b.st = st;
    if (threadIdx.x == 0) (void)xb_add(&bar[XB_XCNT(b.x)], 1u);
    return b;
}
__device__ __forceinline__ void xcd_barrier_complete(unsigned* bar, unsigned x, unsigned& nloc, unsigned& nx) {
    const unsigned G = gridDim.x * gridDim.y * gridDim.z;
    unsigned sum, cnt, mine, sp = 0u;
    for (;;) {
        sum = 0u; cnt = 0u; mine = 0u;
#pragma unroll
        for (unsigned j = 0; j < 16; ++j) { const unsigned c = xb_ld(&bar[XB_XCNT(j)]); sum += c; cnt += (c > 0u) ? 1u : 0u; mine = (j == x) ? c : mine; }
        if (sum == G) break;
        __builtin_amdgcn_s_sleep(1);
        if ((++sp & 255u) == 0u) { if (xb_ld(&bar[XB_TMO])) break; if (sp > XB_SPIN_CAP) { atomicAdd(&bar[XB_TMO], 1u); break; } }
    }
    nloc = mine > 0u ? mine : 1u; nx = cnt > 0u ? cnt : 1u;
}

__device__ __forceinline__ void xcd_barrier(const XcdBarrier& b) {
    asm volatile("s_waitcnt vmcnt(0)" ::: "memory");
    __syncthreads();
    if (threadIdx.x == 0) {
        unsigned* bar = b.bar;
        __builtin_amdgcn_s_waitcnt(0);
        unsigned nloc = b.st[0], nx = b.st[1];
        if (nloc == 0u) { xcd_barrier_complete(bar, b.x, nloc, nx); b.st[0] = nloc; b.st[1] = nx; }
        const unsigned old = xb_add(&bar[XB_XSUB(b.x)], 1u);
        const unsigned gen = old / nloc;
        if (old + 1u == (gen + 1u) * nloc) {
            __builtin_amdgcn_fence(__ATOMIC_RELEASE, "agent");
            asm volatile("s_waitcnt vmcnt(0)" ::: "memory");
            const unsigned og = xb_add(&bar[XB_TOP], 1u);
            const unsigned tg = og / nx;
            if (og + 1u == (tg + 1u) * nx) xb_add(&bar[XB_TOPGEN], 1u);
            else XB_SPIN(xb_ld(&bar[XB_TOPGEN]) == tg, bar);
            __builtin_amdgcn_fence(__ATOMIC_ACQUIRE, "agent");
            xb_add(&bar[XB_XGEN(b.x)], 1u);
            asm volatile("s_waitcnt vmcnt(0)" ::: "memory");
        } else {
            XB_SPIN(xb_ld(&bar[XB_XGEN(b.x)]) == gen, bar);
            __builtin_amdgcn_fence(__ATOMIC_ACQUIRE, "agent");
            asm volatile("s_waitcnt vmcnt(0)" ::: "memory");
        }
    }
    __syncthreads();
}


#ifndef WGM_DEFAULT
#define WGM_DEFAULT 4
#endif
#ifndef WGM_SWAPPED
#define WGM_SWAPPED 6
#endif
#ifndef GEMM_SP2
#define GEMM_SP2 true
#endif
#ifndef GEMM_ALIGN
#define GEMM_ALIGN true
#endif
using pg8::bf16_t; using pg8::bf16x8; using pg8::f32x4; using pg8::u32x4; using pg8::Unit; using pg8::cvt_pk_bf16;
#define LAS __attribute__((address_space(3)))
typedef unsigned u32x2 __attribute__((ext_vector_type(2)));

constexpr int D = 1024, NB = 4, SEQ = 8192, CTXL = 256, DFF = 2816;
constexpr int TLAT = NB * SEQ, TCTX = NB * CTXL, TT = TLAT + TCTX;
constexpr int NTHREADS = 512;
constexpr int LDS_BYTES = 152576;
constexpr size_t SE = (size_t)TT * 512;
constexpr size_t SB = SE * 2;

enum { I_X = 0, I_C, I_CTX, I_CCTX, I_NORMG, I_ADAW, I_ADAB, I_WG, I_WU, I_WD, I_FINALG,
       I_EWIN, I_EMU, I_EW0, I_EWUP, I_EA0, I_EAUP, I_EGUP, I_EKK, I_EKA, I_ERK, I_EGNG, I_EGNB,
       I_ELRE, I_ELIM, I_ELOGDT, I_EBRE, I_EBIM, I_ECRE, I_ECIM, I_ED, I_EWGLU, I_EBGLU, I_EWOUT,
       I_OWIN, I_OCW, I_OCB, I_OFW1, I_OFB1, I_OFW2, I_OFB2, I_OFW3, I_OFB3, I_OFW4, I_OFREQ, I_OBIAS, I_OWOUT, N_IN };

constexpr size_t OFF_MODS = 16384;
constexpr size_t MODS_BYTES = (size_t)4 * 5 * 9216 * 4;
constexpr size_t OFF_MPART = OFF_MODS + MODS_BYTES;
constexpr size_t OFF_XC = OFF_MPART + 8 * MODS_BYTES;
constexpr size_t OFF_HDN = OFF_XC + (size_t)TCTX * D * 4;
constexpr size_t OFF_HDNC = OFF_HDN + (size_t)2 * 8192 * 64 * 4;
constexpr size_t OFF_HDNB = OFF_HDNC + (size_t)256 * 64 * 4;
constexpr size_t OFF_W1 = OFF_HDNB + (size_t)2 * 8192 * 64 * 2;
constexpr size_t W1_BYTES = (size_t)5632 * 1024 * 2;
constexpr size_t OFF_W2 = OFF_W1 + 2 * W1_BYTES;
constexpr size_t W2_BYTES = (size_t)1024 * 2816 * 2;
constexpr size_t OFF_WMIX = OFF_W2 + 2 * W2_BYTES;
constexpr size_t WMIX_BYTES = 10485760;
constexpr size_t WM_EWIN = 0, WM_ELORA = 5242880, WM_EGLU = WM_ELORA + 1966080, WM_EOUT = WM_EGLU + 524288;
constexpr size_t WM_OWIN = 0, WM_OOUT = 6291456;
constexpr size_t OFF_H = OFF_WMIX + WMIX_BYTES;
constexpr size_t OFF_BIG = OFF_H + (size_t)TT * D * 2;
constexpr size_t B_U = 0, B_PR = SB, B_RVK = 5 * SB, B_G = 9 * SB, B_LORA = 10 * SB, B_O = 10 * SB, B_YS = 12 * SB;
constexpr size_t B_PT = 0, B_ZT = 6 * SB, B_KS = 8 * SB;
constexpr size_t WS_END = OFF_BIG + 14 * SB;
static_assert(WS_END <= 636508160ull, "workspace too large");
static_assert(B_KS + (size_t)256 * (2 * 16384 + 8192) * 8 <= 14 * SB, "hyena scratch");

enum { PH_PREP_A = 0, PH_PREP_B, PH_CONV_NORM, PH_NORM, PH_F1, PH_F2, PH_E1, PH_FEAT, PH_E3, PH_SCAN, PH_READ, PH_GLU, PH_EOUT,
       PH_O1, PH_HY, PH_TR, PH_OOUT, PH_FINAL };
struct Phase { int type, l, a, b; };
struct Params { const float* in[N_IN]; float* out; char* ws; int nph; int pad; Phase ph[128]; };
typedef const __attribute__((address_space(4))) Params* PP;

__device__ __forceinline__ float bf2f(unsigned short v) { return __uint_as_float(((unsigned)v) << 16); }
__device__ __forceinline__ unsigned short f2bf(float f) { unsigned u = __float_as_uint(f); u += 0x7FFFu + ((u >> 16) & 1u); return (unsigned short)(u >> 16); }
__device__ __forceinline__ unsigned pk2(float a, float b) { return (unsigned)f2bf(a) | ((unsigned)f2bf(b) << 16); }
__device__ __forceinline__ float lo16(unsigned w) { return __uint_as_float(w << 16); }
__device__ __forceinline__ float hi16(unsigned w) { return __uint_as_float(w & 0xffff0000u); }
__device__ __forceinline__ float wave_sum(float v) {
#pragma unroll
    for (int o = 1; o < 64; o <<= 1) v += __shfl_xor(v, o);
    return v;
}
__device__ __forceinline__ float sigm(float x) { return __builtin_amdgcn_rcpf(1.f + __expf(-x)); }
__device__ __forceinline__ float tanh_fast(float x) { return 1.f - 2.f * __builtin_amdgcn_rcpf(1.f + __expf(2.f * x)); }
template <int CTRL> __device__ __forceinline__ float dpp_mov(float x) { return __int_as_float(__builtin_amdgcn_update_dpp(0, __float_as_int(x), CTRL, 0xF, 0xF, true)); }
__device__ __forceinline__ float red16(float x) { x += dpp_mov<0xB1>(x); x += dpp_mov<0x4E>(x); x += dpp_mov<0x124>(x); x += dpp_mov<0x128>(x); return x; }
__device__ __forceinline__ void red16x2(float& a, float& b) { a += dpp_mov<0xB1>(a); b += dpp_mov<0xB1>(b); a += dpp_mov<0x4E>(a); b += dpp_mov<0x4E>(b); a += dpp_mov<0x124>(a); b += dpp_mov<0x124>(b); a += dpp_mov<0x128>(a); b += dpp_mov<0x128>(b); }
#define LDS_FENCE() asm volatile("s_waitcnt lgkmcnt(0)" ::: "memory")

struct EpiSwiglu {
    static constexpr bool PERM = true, AFTER_DRAIN = false;
    bf16_t* O;
    __device__ __forceinline__ void operator()(const f32x4 (&acc)[2][2][4][2], const Unit& u, int wr, int wc, int fr, int fq) const {
        const int row0 = u.pm * 256 + wr * 64 + fr, col0 = u.pn * 128 + wc * 32 + 8 * fq;
#pragma unroll
        for (int ai = 0; ai < 2; ++ai)
#pragma unroll
            for (int m = 0; m < 4; ++m) { bf16_t* rowp = O + (size_t)(row0 + ai * 128 + m * 16) * DFF + col0;
                const f32x4 g0 = acc[ai][0][m][0], g1 = acc[ai][0][m][1], u0 = acc[ai][1][m][0], u1 = acc[ai][1][m][1];
                u32x4 w;
                w.x = cvt_pk_bf16(g0[0] * sigm(g0[0]) * u0[0], g0[1] * sigm(g0[1]) * u0[1]); w.y = cvt_pk_bf16(g0[2] * sigm(g0[2]) * u0[2], g0[3] * sigm(g0[3]) * u0[3]);
                w.z = cvt_pk_bf16(g1[0] * sigm(g1[0]) * u1[0], g1[1] * sigm(g1[1]) * u1[1]); w.w = cvt_pk_bf16(g1[2] * sigm(g1[2]) * u1[2], g1[3] * sigm(g1[3]) * u1[3]);
                *(u32x4*)rowp = w; }
    }
};
struct EpiBf16Out {
    static constexpr bool PERM = true, AFTER_DRAIN = false;
    bf16_t* O0; int ld0; int nt0; bf16_t* O1; int ld1;
    __device__ __forceinline__ void operator()(const f32x4 (&acc)[2][2][4][2], const Unit& u, int wr, int wc, int fr, int fq) const {
        const int row0 = u.pm * 256 + wr * 64 + fr;
        bf16_t* base; int ld, colt;
        if (u.pn < nt0) { base = O0; ld = ld0; colt = u.pn * 256; } else { base = O1; ld = ld1; colt = (u.pn - nt0) * 256; }
        const int col0 = colt + wc * 32 + 8 * fq;
#pragma unroll
        for (int ai = 0; ai < 2; ++ai)
#pragma unroll
            for (int m = 0; m < 4; ++m) { bf16_t* rowp = base + (size_t)(row0 + ai * 128 + m * 16) * ld + col0;
#pragma unroll
                for (int bj = 0; bj < 2; ++bj) { const f32x4 v0 = acc[ai][bj][m][0], v1 = acc[ai][bj][m][1];
                    u32x4 w; w.x = cvt_pk_bf16(v0[0], v0[1]); w.y = cvt_pk_bf16(v0[2], v0[3]); w.z = cvt_pk_bf16(v1[0], v1[1]); w.w = cvt_pk_bf16(v1[2], v1[3]);
                    *(u32x4*)(rowp + bj * 128) = w; } }
    }
};
struct EpiLora {
    static constexpr bool PERM = true, AFTER_DRAIN = false;
    bf16_t* EA; bf16_t* G; const float* w0; const float* a0;
    __device__ __forceinline__ void operator()(const f32x4 (&acc)[2][2][4][2], const Unit& u, int wr, int wc, int fr, int fq) const {
        const int row0 = u.pm * 256 + wr * 64 + fr; const int type = u.pn >> 1; const int col0 = (u.pn & 1) * 256 + wc * 32 + 8 * fq;
        bf16_t* base = (type < 4 ? EA + (size_t)type * SE : G) + (size_t)row0 * 512 + col0;
        const float* bias = (type < 2 ? w0 + type * 512 : a0 + (type & 1) * 512) + col0;
        const float mul = type < 2 ? 0.60653065971f : 1.0f;
        if (type < 4) {
#pragma unroll
            for (int bj = 0; bj < 2; ++bj) {
                const f32x4 b0 = *(const f32x4*)(bias + bj * 128), b1 = *(const f32x4*)(bias + bj * 128 + 4);
#pragma unroll
                for (int ai = 0; ai < 2; ++ai)
#pragma unroll
                    for (int m = 0; m < 4; ++m) { f32x4 v0 = acc[ai][bj][m][0] + b0, v1 = acc[ai][bj][m][1] + b1;
#pragma unroll
                        for (int j = 0; j < 4; ++j) { v0[j] = mul * sigm(v0[j]); v1[j] = mul * sigm(v1[j]); }
                        u32x4 w; w.x = cvt_pk_bf16(v0[0], v0[1]); w.y = cvt_pk_bf16(v0[2], v0[3]); w.z = cvt_pk_bf16(v1[0], v1[1]); w.w = cvt_pk_bf16(v1[2], v1[3]);
                        *(u32x4*)(base + (size_t)(ai * 128 + m * 16) * 512 + bj * 128) = w; } }
        } else {
#pragma unroll
            for (int bj = 0; bj < 2; ++bj)
#pragma unroll
                for (int ai = 0; ai < 2; ++ai)
#pragma unroll
                    for (int m = 0; m < 4; ++m) { const f32x4 v0 = acc[ai][bj][m][0], v1 = acc[ai][bj][m][1];
                        u32x4 w; w.x = cvt_pk_bf16(v0[0], v0[1]); w.y = cvt_pk_bf16(v0[2], v0[3]); w.z = cvt_pk_bf16(v1[0], v1[1]); w.w = cvt_pk_bf16(v1[2], v1[3]);
                        *(u32x4*)(base + (size_t)(ai * 128 + m * 16) * 512 + bj * 128) = w; }
        }
    }
};
struct EpiGlu {
    static constexpr bool PERM = true, AFTER_DRAIN = false;
    const bf16_t* YG; bf16_t* YCAT; const float* bglu;
    __device__ __forceinline__ void operator()(const f32x4 (&acc)[2][2][4][2], const Unit& u, int wr, int wc, int fr, int fq) const {
        const int row0 = u.pm * 256 + wr * 64 + fr; const int col0 = u.pn * 256 + wc * 32 + 8 * fq;
        f32x4 bv[2][2];
#pragma unroll
        for (int bj = 0; bj < 2; ++bj)
#pragma unroll
            for (int n = 0; n < 2; ++n) bv[bj][n] = *(const f32x4*)(bglu + col0 + bj * 128 + 4 * n);
#pragma unroll
        for (int ai = 0; ai < 2; ++ai)
#pragma unroll
            for (int m = 0; m < 4; ++m) { const size_t row = (size_t)(row0 + ai * 128 + m * 16);
#pragma unroll
                for (int bj = 0; bj < 2; ++bj) { f32x4 v0 = acc[ai][bj][m][0] + bv[bj][0], v1 = acc[ai][bj][m][1] + bv[bj][1];
                    const u32x4 y = *(const u32x4*)(YG + row * 512 + col0 + bj * 128);
                    v0[0] = lo16(y.x) * sigm(v0[0]); v0[1] = hi16(y.x) * sigm(v0[1]); v0[2] = lo16(y.y) * sigm(v0[2]); v0[3] = hi16(y.y) * sigm(v0[3]);
                    v1[0] = lo16(y.z) * sigm(v1[0]); v1[1] = hi16(y.z) * sigm(v1[1]); v1[2] = lo16(y.w) * sigm(v1[2]); v1[3] = hi16(y.w) * sigm(v1[3]);
                    u32x4 w; w.x = cvt_pk_bf16(v0[0], v0[1]); w.y = cvt_pk_bf16(v0[2], v0[3]); w.z = cvt_pk_bf16(v1[0], v1[1]); w.w = cvt_pk_bf16(v1[2], v1[3]);
                    *(u32x4*)(YCAT + row * 1024 + 512 + col0 + bj * 128) = w; } }
    }
};
struct EpiResid {
    static constexpr bool PERM = false, AFTER_DRAIN = false;
    const float* in_lat; const float* in_ctx; float* out_lat; float* out_ctx; const float* gate; float scale;
    __device__ __forceinline__ void operator()(const f32x4 (&acc)[2][2][4][2], const Unit& u, int wr, int wc, int fr, int fq) const {
        const bool isctx = u.pm >= 128; const int ci = isctx ? 4 : (u.pm >> 5);
        const int row0 = (isctx ? (u.pm - 128) * 256 : u.pm * 256) + wr * 64 + fr, col0 = u.pn * 256 + wc * 32 + 4 * fq;
        const float* src = isctx ? in_ctx : in_lat; float* dst = isctx ? out_ctx : out_lat; const float* gp = gate + (size_t)ci * 9216;
        f32x4 gv[2][2];
#pragma unroll
        for (int bj = 0; bj < 2; ++bj)
#pragma unroll
            for (int n = 0; n < 2; ++n) gv[bj][n] = *(const f32x4*)(gp + col0 + bj * 128 + n * 16) * scale;
#pragma unroll
        for (int ai = 0; ai < 2; ++ai)
#pragma unroll
            for (int m = 0; m < 4; ++m) { const size_t ro = (size_t)(row0 + ai * 128 + m * 16) * D + col0;
#pragma unroll
                for (int bj = 0; bj < 2; ++bj)
#pragma unroll
                    for (int n = 0; n < 2; ++n) { const f32x4 x = *(const f32x4*)(src + ro + bj * 128 + n * 16);
                        *(f32x4*)(dst + ro + bj * 128 + n * 16) = x + gv[bj][n] * acc[ai][bj][m][n]; } }
    }
};
struct EpiPartial {
    static constexpr bool PERM = false, AFTER_DRAIN = false;
    float* out; const float* gate; float scale;
    __device__ __forceinline__ void operator()(const f32x4 (&acc)[2][2][4][2], const Unit& u, int wr, int wc, int fr, int fq) const {
        const int row0 = u.pm * 256 + wr * 64 + fr, col0 = u.pn * 256 + wc * 32 + 4 * fq;
        f32x4 gv[2][2];
#pragma unroll
        for (int bj = 0; bj < 2; ++bj)
#pragma unroll
            for (int n = 0; n < 2; ++n) gv[bj][n] = *(const f32x4*)(gate + col0 + bj * 128 + n * 16) * scale;
#pragma unroll
        for (int ai = 0; ai < 2; ++ai)
#pragma unroll
            for (int m = 0; m < 4; ++m) { float* rp = out + (size_t)(row0 + ai * 128 + m * 16) * D + col0;
#pragma unroll
                for (int bj = 0; bj < 2; ++bj)
#pragma unroll
                    for (int n = 0; n < 2; ++n) *(f32x4*)(rp + bj * 128 + n * 16) = gv[bj][n] * acc[ai][bj][m][n]; }
    }
};
struct OneUnit { Unit u; int has;
    __device__ __forceinline__ bool next(int i, Unit& o) const { if (i == 0 && has) { o = u; return true; } return false; }
    __device__ __forceinline__ void a_ready(const Unit&) const {}
    __device__ __forceinline__ void done(const Unit&) const {} };
__device__ __forceinline__ void ctx_splitk(LAS unsigned char* lds, const bf16_t* Actx, const bf16_t* Bt, int K, float* PART, const float* gate, float scale) {
    const int nk = K / 256, nsub = 16 * nk; int blk = bidx();
    OneUnit S; S.has = blk < nsub ? 1 : 0; const int unit = S.has ? blk / nk : 0, kc = S.has ? blk % nk : 0; S.u.pm = unit >> 2; S.u.pn = unit & 3;
    int Kl = 256, Ks = K; asm volatile("" : "+s"(Kl), "+s"(Ks));
    pg8::Gemm g; g.A = Actx + kc * 256; g.Bt = Bt + kc * 256; g.M = 1024; g.N = 1024; g.K = Ks; g.Kloop = Kl;
    EpiPartial E; E.out = PART + (size_t)kc * TCTX * D; E.gate = gate; E.scale = scale;
    pg8::gemm_phase<EpiPartial, OneUnit, false, GEMM_SP2>(lds, g, S, E);
}
template <class Epi> __device__ __forceinline__ void run_gemm(LAS unsigned char* lds, const bf16_t* A, const bf16_t* Bt, int M, int N, int K, const Epi& E, int wgm = WGM_DEFAULT) {
    asm volatile("" : "+s"(M), "+s"(N), "+s"(K));
    pg8::Gemm g; g.A = A; g.Bt = Bt; g.M = M; g.N = N; g.K = K; g.Kloop = K;
    pg8::StaticOrder S; S.init(M, N, (int)gridDim.x, bidx()); S.wgm = wgm;
    pg8::gemm_phase<Epi, pg8::StaticOrder, GEMM_ALIGN, GEMM_SP2>(lds, g, S, E);
}

__device__ __forceinline__ void tr_tile(const float* src, int N, int k0, int n0, bf16_t* dst, int ldd, int rmul, int radd, LAS float* tile) {
    const int tid = tidx();
#pragma unroll
    for (int i = 0; i < 8; ++i) { const int k = i * 8 + (tid >> 6), n = tid & 63; tile[k * 65 + n] = src[(size_t)(k0 + k) * N + n0 + n]; }
    __syncthreads();
    { const int n = tid >> 3, c = tid & 7; const LAS float* s = tile + (c * 8) * 65 + n;
      u32x4 o; o.x = pk2(s[0], s[65]); o.y = pk2(s[130], s[195]); o.z = pk2(s[260], s[325]); o.w = pk2(s[390], s[455]);
      *(u32x4*)(dst + (size_t)(rmul * (n0 + n) + radd) * ldd + k0 + c * 8) = o; }
    __syncthreads();
}
__device__ __forceinline__ void norm_rows(const float* in_lat, const float* in_ctx, int nrows, const float* gain, const float* mods_l, int jshift, int jscale, bf16_t* H, const float* PART, int nkpend, float* XCw) {
    const int lane = tidx() & 63, gw = bidx() * 8 + (tidx() >> 6), NGW = gridDim.x * 8;
    for (int row0 = gw; row0 < nrows; row0 += 4 * NGW) {
        f32x4 v[4][4];
#pragma unroll
        for (int q = 0; q < 4; ++q) { const int row = row0 + q * NGW;
            if (row < nrows) { const bool isctx = row >= TLAT; const float* src = isctx ? in_ctx + (size_t)(row - TLAT) * D : in_lat + (size_t)row * D;
#pragma unroll
                for (int j = 0; j < 4; ++j) v[q][j] = *(const f32x4*)(src + 4 * lane + 256 * j); } }
#pragma unroll
        for (int q = 0; q < 4; ++q) { const int row = row0 + q * NGW;
            if (row >= nrows) continue;
            const bool isctx = row >= TLAT; const int ci = isctx ? 4 : (row >> 13);
            const float* sh = mods_l + (size_t)ci * 9216 + jshift * 1024; const float* sc = mods_l + (size_t)ci * 9216 + jscale * 1024;
            if (isctx && nkpend > 0) {
                const float* pp = PART + (size_t)(row - TLAT) * D + 4 * lane;
                int k = 0;
                for (; k + 4 <= nkpend; k += 4) {
                    f32x4 t[4][4];
#pragma unroll
                    for (int kk = 0; kk < 4; ++kk)
#pragma unroll
                        for (int j = 0; j < 4; ++j) t[kk][j] = *(const f32x4*)(pp + (size_t)(k + kk) * TCTX * D + 256 * j);
#pragma unroll
                    for (int kk = 0; kk < 4; ++kk)
#pragma unroll
                        for (int j = 0; j < 4; ++j) v[q][j] += t[kk][j]; }
                for (; k < nkpend; ++k) {
#pragma unroll
                    for (int j = 0; j < 4; ++j) v[q][j] += *(const f32x4*)(pp + (size_t)k * TCTX * D + 256 * j); }
#pragma unroll
                for (int j = 0; j < 4; ++j) *(f32x4*)(XCw + (size_t)(row - TLAT) * D + 4 * lane + 256 * j) = v[q][j];
            }
            float s = 0.f;
#pragma unroll
            for (int j = 0; j < 4; ++j) s += (v[q][j][0] * v[q][j][0] + v[q][j][1] * v[q][j][1]) + (v[q][j][2] * v[q][j][2] + v[q][j][3] * v[q][j][3]);
            const float rstd = rsqrtf(wave_sum(s) * (1.f / D) + 1e-6f);
#pragma unroll
            for (int j = 0; j < 4; ++j) { const int c = 4 * lane + 256 * j;
                const f32x4 g = *(const f32x4*)(gain + c), a = *(const f32x4*)(sc + c), b = *(const f32x4*)(sh + c);
                f32x4 y = v[q][j] * rstd * g * (a + 1.0f) + b;
                u32x2 w; w.x = pk2(y[0], y[1]); w.y = pk2(y[2], y[3]);
                *(u32x2*)(H + (size_t)row * D + c) = w; }
        }
    }
}

__device__ __forceinline__ void hdn_task(PP P, int io, int L, int posblk, float* out, bf16_t* outb, LAS float* lds, const LAS float* wl) {
    const int tid = tidx(), pp = tid >> 6, u = tid & 63, pos = posblk * 8 + pp;
    LAS float* feat = lds; LAS float* h1 = lds + 512; LAS float* h2 = lds + 1024;
    if (u < 33) {
        float f;
        if (u == 0) f = (float)pos / (float)(L - 1);
        else { const int bi = (u - 1) & 15; const float band = 1e-4f + (float)bi * ((15.0f - 1e-4f) / 15.0f); const float ang = 6.283185307179586f * (float)pos / (float)L;
               f = (u <= 16) ? cosf(band * ang) : -sinf(band * ang); }
        feat[pp * 36 + u] = f;
    }
    __syncthreads();
    const float fr = P->in[I_OFREQ][io * 64 + u];
    { float acc = P->in[I_OFB1][io * 64 + u];
#pragma unroll
      for (int f = 0; f < 33; ++f) acc += feat[pp * 36 + f] * wl[f * 64 + u];
      h1[pp * 64 + u] = sinf(fr * acc); }
    __syncthreads();
    { float acc = P->in[I_OFB2][io * 64 + u];
#pragma unroll 16
      for (int k = 0; k < 64; ++k) acc += h1[pp * 64 + k] * wl[2112 + k * 64 + u];
      h2[pp * 64 + u] = sinf(fr * acc); }
    __syncthreads();
    { float acc = P->in[I_OFB3][io * 64 + u];
#pragma unroll 16
      for (int k = 0; k < 64; ++k) acc += h2[pp * 64 + k] * wl[6208 + k * 64 + u];
      const float hv = sinf(fr * acc); out[(size_t)pos * 64 + u] = hv; if (outb) outb[(size_t)pos * 64 + u] = f2bf(hv); }
    __syncthreads();
}
__device__ __forceinline__ void prep_a(PP P, LAS float* lds) {
    const int tid = tidx();
    float* part = (float*)(P->ws + OFF_MPART);
    for (int task = bidx(); task < 4 * 18 * 8; task += gridDim.x) {
        const int ks = task & 7, nb = (task >> 3) % 18, l = task / 144;
        for (int idx = tid; idx < 640; idx += NTHREADS) { const int ci = idx >> 7, k = idx & 127;
            const float cv = ci < 4 ? P->in[I_C][ci * 1024 + ks * 128 + k] : P->in[I_CCTX][ks * 128 + k];
            lds[idx] = cv / (1.f + expf(-cv)); }
        __syncthreads();
        const int n = nb * 512 + tid; float a0 = 0.f, a1 = 0.f, a2 = 0.f, a3 = 0.f, a4 = 0.f;
        const float* w = P->in[I_ADAW] + ((size_t)l * 1024 + ks * 128) * 9216 + n;
#pragma unroll 32
        for (int k = 0; k < 128; ++k) { const float wv = w[(size_t)k * 9216];
            a0 += lds[k] * wv; a1 += lds[128 + k] * wv; a2 += lds[256 + k] * wv; a3 += lds[384 + k] * wv; a4 += lds[512 + k] * wv; }
        float* po = part + ((size_t)(ks * 4 + l) * 5) * 9216 + n;
        po[0] = a0; po[9216] = a1; po[2 * 9216] = a2; po[3 * 9216] = a3; po[4 * 9216] = a4;
        __syncthreads();
    }
    { float* XCp = (float*)(P->ws + OFF_XC); const float* cx = P->in[I_CTX];
      for (int idx = bidx() * NTHREADS + tid; idx < TCTX * D / 4; idx += gridDim.x * NTHREADS) ((f32x4*)XCp)[idx] = ((const f32x4*)cx)[idx]; }
    float* hdn = (float*)(P->ws + OFF_HDN); float* hdnc = (float*)(P->ws + OFF_HDNC);
    LAS float* wl = lds + 2048; int cur_io = -1;
    for (int task = bidx(); task < 2 * 1024 + 32; task += gridDim.x) {
        const int io = task < 2048 ? (task >> 10) : 0;
        if (io != cur_io) { __syncthreads();
            for (int idx = tid; idx < 33 * 64; idx += NTHREADS) wl[idx] = P->in[I_OFW1][(size_t)io * 33 * 64 + idx];
            for (int idx = tid; idx < 4096; idx += NTHREADS) { wl[2112 + idx] = P->in[I_OFW2][(size_t)io * 4096 + idx]; wl[6208 + idx] = P->in[I_OFW3][(size_t)io * 4096 + idx]; }
            cur_io = io; __syncthreads(); }
        if (task < 2048) hdn_task(P, io, 8192, task & 1023, hdn + (size_t)io * 8192 * 64, (bf16_t*)(P->ws + OFF_HDNB) + (size_t)io * 8192 * 64, lds, wl);
        else hdn_task(P, 0, 256, task - 2048, hdnc, nullptr, lds, wl);
    }
}
__device__ __forceinline__ void prep_b(PP P) {
    const float* part = (const float*)(P->ws + OFF_MPART); float* mods = (float*)(P->ws + OFF_MODS);
    for (int idx = bidx() * NTHREADS + tidx(); idx < 4 * 5 * 9216; idx += gridDim.x * NTHREADS) {
        const int n = idx % 9216, l = idx / (5 * 9216);
        float s = P->in[I_ADAB][l * 9216 + n];
#pragma unroll
        for (int ks = 0; ks < 8; ++ks) s += part[(size_t)ks * 4 * 5 * 9216 + idx];
        mods[idx] = s;
    }
}
__device__ __forceinline__ void conv_weights(PP P, int l, LAS float* tile) {
    const int i = l >> 1; const bool even = (l & 1) == 0;
    bf16_t* W1 = (bf16_t*)(P->ws + OFF_W1); bf16_t* W2 = (bf16_t*)(P->ws + OFF_W2); char* WM = P->ws + OFF_WMIX;
    const int nmix = even ? (608 + 64 + 256) : (768 + 256);
    const int ntiles = 6 * 704 + nmix;
    struct TD { const float* src; int N, k0, n0; bf16_t* dst; int ldd, rmul, radd; };
    auto decode = [&](int t) -> TD { TD d;
        if (t < 6 * 704) {
            const int mtx = t / 704, r = t % 704, hf = mtx / 3, kind = mtx % 3;
            if (kind < 2) { d.src = P->in[kind == 0 ? I_WG : I_WU] + (size_t)(l * 2 + hf) * 1024 * DFF; d.N = DFF; d.k0 = (r / 44) * 64; d.n0 = (r % 44) * 64;
                d.dst = W1 + (size_t)hf * 5632 * 1024; d.ldd = 1024; d.rmul = 1; d.radd = (d.n0 >> 7) * 256 + (d.n0 & 127) + kind * 128 - d.n0; }
            else { d.src = P->in[I_WD] + (size_t)(l * 2 + hf) * DFF * 1024; d.N = 1024; d.k0 = (r / 16) * 64; d.n0 = (r % 16) * 64;
                d.dst = W2 + (size_t)hf * 1024 * DFF; d.ldd = DFF; d.rmul = 1; d.radd = 0; }
        } else {
            int r = t - 6 * 704; d.rmul = 1; d.radd = 0;
            if (even) {
                if (r < 608) { d.src = P->in[I_EWIN] + (size_t)i * 1024 * 2432; d.N = 2432; d.k0 = (r / 38) * 64; d.n0 = (r % 38) * 64; d.dst = (bf16_t*)(WM + WM_EWIN); d.ldd = 1024; d.radd = d.n0 < 1920 ? 512 : -1920; }
                else if (r < 672) { r -= 608; d.src = P->in[I_EWGLU] + (size_t)i * 512 * 512; d.N = 512; d.k0 = (r >> 3) * 64; d.n0 = (r & 7) * 64; d.dst = (bf16_t*)(WM + WM_EGLU); d.ldd = 512; }
                else { r -= 672; d.src = P->in[I_EWOUT] + (size_t)i * 1024 * 1024; d.N = 1024; d.k0 = (r >> 4) * 64; d.n0 = (r & 15) * 64; d.dst = (bf16_t*)(WM + WM_EOUT); d.ldd = 1024; }
            } else {
                if (r < 768) { d.src = P->in[I_OWIN] + (size_t)i * 1024 * 3072; d.N = 3072; d.k0 = (r / 48) * 64; d.n0 = (r % 48) * 64; d.dst = (bf16_t*)(WM + WM_OWIN); d.ldd = 1024; }
                else { r -= 768; d.src = P->in[I_OWOUT] + (size_t)i * 1024 * 1024; d.N = 1024; d.k0 = (r >> 4) * 64; d.n0 = (r & 15) * 64; d.dst = (bf16_t*)(WM + WM_OOUT); d.ldd = 1024; }
            }
        }
        return d; };
    const int tid = tidx();
    auto tload = [&](const TD& d, float (&r)[8]) {
#pragma unroll
        for (int q = 0; q < 8; ++q) r[q] = d.src[(size_t)(d.k0 + q * 8 + (tid >> 6)) * d.N + d.n0 + (tid & 63)]; };
    auto tstore = [&](const TD& d, const float (&r)[8]) {
#pragma unroll
        for (int q = 0; q < 8; ++q) tile[(q * 8 + (tid >> 6)) * 65 + (tid & 63)] = r[q];
        __syncthreads();
        { const int n = tid >> 3, c = tid & 7; const LAS float* sp = tile + (c * 8) * 65 + n;
          u32x4 o; o.x = pk2(sp[0], sp[65]); o.y = pk2(sp[130], sp[195]); o.z = pk2(sp[260], sp[325]); o.w = pk2(sp[390], sp[455]);
          *(u32x4*)(d.dst + (size_t)(d.rmul * (d.n0 + n) + d.radd) * d.ldd + d.k0 + c * 8) = o; }
        __syncthreads(); };
    { int t = bidx(); TD cur, nxt; float rc[8], rn[8];
      if (t < ntiles) { cur = decode(t); tload(cur, rc); }
      while (t < ntiles) { const int tn = t + (int)gridDim.x;
          if (tn < ntiles) { nxt = decode(tn); tload(nxt, rn); }
          tstore(cur, rc);
          cur = nxt;
#pragma unroll
          for (int q = 0; q < 8; ++q) rc[q] = rn[q];
          t = tn; } }
    if (even) {
        bf16_t* WL = (bf16_t*)(WM + WM_ELORA);
        for (int idx = bidx() * NTHREADS + tidx(); idx < 2560 * 384; idx += gridDim.x * NTHREADS) {
            const int n = idx / 384, k = idx % 384, type = n >> 9, c = n & 511; float v = 0.f;
            if (type == 0 && k < 64) v = P->in[I_EWUP][((size_t)(i * 2 + 0) * 64 + k) * 512 + c];
            else if (type == 1 && k >= 64 && k < 128) v = P->in[I_EWUP][((size_t)(i * 2 + 1) * 64 + (k - 64)) * 512 + c];
            else if (type == 2 && k >= 128 && k < 192) v = P->in[I_EAUP][((size_t)(i * 2 + 0) * 64 + (k - 128)) * 512 + c];
            else if (type == 3 && k >= 192 && k < 256) v = P->in[I_EAUP][((size_t)(i * 2 + 1) * 64 + (k - 192)) * 512 + c];
            else if (type == 4 && k >= 256) v = P->in[I_EGUP][((size_t)i * 128 + (k - 256)) * 512 + c];
            WL[idx] = f2bf(v);
        }
    }
}
__device__ __forceinline__ void feat_phase(PP P, int i) {
    const int lane = tidx() & 63, gw = bidx() * 8 + (tidx() >> 6), NGW = gridDim.x * 8;
    char* big = P->ws + OFF_BIG;
    const bf16_t* PR = (const bf16_t*)(big + B_PR);
    bf16_t* R = (bf16_t*)(big + B_RVK); bf16_t* KR = R + SE; bf16_t* V = R + 2 * SE; bf16_t* KK = R + 3 * SE; bf16_t* LIN = (bf16_t*)(big + B_LORA);
    const float* mu = P->in[I_EMU] + (size_t)i * 1920; const float* k_k = P->in[I_EKK] + (size_t)i * 512;
    for (int row = gw; row < TT; row += NGW) {
        int r0, r1, r2, r3;
        if (row < TLAT) { const int t = row & 8191, x = t & 63, y = t >> 6;
            r0 = x > 0 ? row - 1 : -1; r1 = x < 63 ? row + 1 : -1; r2 = y > 0 ? row - 64 : -1; r3 = y < 127 ? row + 64 : -1; }
        else { const int t = (row - TLAT) & 255; r0 = t > 0 ? row - 1 : -1; r1 = t < 255 ? row + 1 : -1; r2 = r0; r3 = r1; }
        u32x2 pwv[8]; unsigned short nb[8][4];
#pragma unroll
        for (int it = 0; it < 8; ++it) {
            const int gi = it * 64 + lane; const bool act = gi < 480; const int c0 = act ? 4 * gi : 0;
            pwv[it] = *(const u32x2*)(PR + (size_t)row * 2048 + c0);
            nb[it][0] = r0 >= 0 ? PR[(size_t)r0 * 2048 + c0 + 0] : (unsigned short)0;
            nb[it][1] = r1 >= 0 ? PR[(size_t)r1 * 2048 + c0 + 1] : (unsigned short)0;
            nb[it][2] = r2 >= 0 ? PR[(size_t)r2 * 2048 + c0 + 2] : (unsigned short)0;
            nb[it][3] = r3 >= 0 ? PR[(size_t)r3 * 2048 + c0 + 3] : (unsigned short)0;
        }
#pragma unroll
        for (int it = 0; it < 8; ++it) {
            const int gi = it * 64 + lane; const bool act = gi < 480; const int c0 = act ? 4 * gi : 0;
            const u32x2 pw = pwv[it];
            float p[4] = {lo16(pw.x), hi16(pw.x), lo16(pw.y), hi16(pw.y)};
            float pn[4] = {bf2f(nb[it][0]), bf2f(nb[it][1]), bf2f(nb[it][2]), bf2f(nb[it][3])};
            const f32x4 m4 = *(const f32x4*)(mu + c0);
            float q[4];
#pragma unroll
            for (int j = 0; j < 4; ++j) q[j] = p[j] + m4[j] * (pn[j] - p[j]);
            const bool isk = act && c0 >= 512 && c0 < 1024;
            float kr4[4] = {0.f, 0.f, 0.f, 0.f}; float ss = 0.f;
            if (isk) { const f32x4 kk4 = *(const f32x4*)(k_k + (c0 - 512));
#pragma unroll
                for (int j = 0; j < 4; ++j) { kr4[j] = q[j] * kk4[j]; ss += kr4[j] * kr4[j]; } }
            ss = red16(ss);
            if (!act) continue;
            if (c0 < 512) { u32x2 w; w.x = pk2(q[0], q[1]); w.y = pk2(q[2], q[3]); *(u32x2*)(R + (size_t)row * 512 + c0) = w; }
            else if (c0 < 1024) { u32x2 w; w.x = pk2(q[0], q[1]); w.y = pk2(q[2], q[3]); *(u32x2*)(KR + (size_t)row * 512 + (c0 - 512)) = w;
                const float inv = 1.f / fmaxf(sqrtf(ss), 1e-12f);
                w.x = pk2(kr4[0] * inv, kr4[1] * inv); w.y = pk2(kr4[2] * inv, kr4[3] * inv); *(u32x2*)(KK + (size_t)row * 512 + (c0 - 512)) = w; }
            else if (c0 < 1536) { u32x2 w; w.x = pk2(q[0], q[1]); w.y = pk2(q[2], q[3]); *(u32x2*)(V + (size_t)row * 512 + (c0 - 1024)) = w; }
            else { float o[4];
                if (c0 < 1664) {
#pragma unroll
                    for (int j = 0; j < 4; ++j) o[j] = tanh_fast(q[j]); }
                else if (c0 < 1792) {
#pragma unroll
                    for (int j = 0; j < 4; ++j) o[j] = q[j]; }
                else {
#pragma unroll
                    for (int j = 0; j < 4; ++j) o[j] = sigm(q[j]); }
                u32x2 w; w.x = pk2(o[0], o[1]); w.y = pk2(o[2], o[3]); *(u32x2*)(LIN + (size_t)row * 384 + (c0 - 1536)) = w; }
        }
    }
}
constexpr int SST = 340;
constexpr int CH = 32;
constexpr int NCHUNK = (CTXL + SEQ) / CH;
__device__ __forceinline__ int row_of_step(int s, int b, int dir) {
    if (s < CTXL) { const int t = dir ? (CTXL - 1 - s) : s; return TLAT + b * CTXL + t; }
    const int t = dir ? (SEQ - 1 - (s - CTXL)) : (s - CTXL); return b * SEQ + t;
}
__device__ __forceinline__ void scan_phase(PP P, int i, LAS unsigned char* ldsb) {
    const int tid = tidx(), wave = tid >> 6, lane = tid & 63;
    char* big = P->ws + OFF_BIG;
    const bf16_t* R = (const bf16_t*)(big + B_RVK); const bf16_t* KR = R + SE; const bf16_t* V = R + 2 * SE; const bf16_t* KK = R + 3 * SE;
    const bf16_t* EA = (const bf16_t*)(big + B_PR); const bf16_t* U = (const bf16_t*)(big + B_U);
    bf16_t* O = (bf16_t*)(big + B_O); bf16_t* YS = (bf16_t*)(big + B_YS);
    LAS float* sbuf = (LAS float*)ldsb;
    LAS float* bul = (LAS float*)(ldsb + 2 * CH * SST * 4);
    LAS bf16_t* hbl = (LAS bf16_t*)(ldsb + 2 * CH * SST * 4 + 16 * 132 * 4);
    for (int item = bidx(); item < 256; item += gridDim.x) {
        const int vi = (item & 7) * 32 + (item >> 3);
        const int b = vi >> 6, head = (vi >> 3) & 7, dir = (vi >> 2) & 1, rq = vi & 3, g = head * 4 + rq;
        const bf16_t* Ed = EA + (size_t)dir * SE; const bf16_t* Ad = EA + (size_t)(2 + dir) * SE;
        bf16_t* Od = O + (size_t)dir * SE; bf16_t* YSd = YS + (size_t)dir * SE;
        pg8::f32x2 sA = {0.f, 0.f}, sB = {0.f, 0.f};
        const int rl = lane >> 4, cg4 = (lane & 15) * 4, il = (wave & 3) * 4 + rl;
        float hre = 0.f, him = 0.f, are = 0.f, aim = 0.f;
        bf16x8 unx = {0, 0, 0, 0, 0, 0, 0, 0};
        LAS float* bul = (LAS float*)(ldsb + 87040);
        LAS bf16_t* hbl = (LAS bf16_t*)(ldsb + 120832);
        LAS bf16x8* bfl = (LAS bf16x8*)(ldsb + 138240); LAS bf16x8* cfl = (LAS bf16x8*)(ldsb + 146432);
        const int kq = lane >> 4, l15 = lane & 15;
        __syncthreads();
        if (wave == 7) {
            const int dg = ((i * 2 + dir) * 32 + g);
            const float lre = P->in[I_ELRE][dg * 64 + lane], lim = P->in[I_ELIM][dg * 64 + lane];
            const float dt = expf(P->in[I_ELOGDT][dg]);
            const float er = expf(lre * dt); float sn, cs; sincosf(lim * dt, &sn, &cs);
            are = er * cs; aim = er * sn;
            const float xr = are - 1.f, xi = aim, den = 1.f / (lre * lre + lim * lim);
            const float czr = (xr * lre + xi * lim) * den, czi = (xi * lre - xr * lim) * den;
#pragma unroll 1
            for (int nt = 0; nt < 8; ++nt) {
                const int col = nt * 16 + l15, pp = col >> 1, part = col & 1;
                const float cr = __shfl(czr, pp), cim = __shfl(czi, pp);
                bf16x8 f;
#pragma unroll
                for (int j = 0; j < 8; ++j) { float v = 0.f;
                    if (kq < 2) { const int h = kq * 8 + j; const float br = P->in[I_EBRE][((size_t)dg * 64 + pp) * 16 + h], bi = P->in[I_EBIM][((size_t)dg * 64 + pp) * 16 + h];
                        v = part ? (cr * bi + cim * br) : (cr * br - cim * bi); }
                    f[j] = (short)f2bf(v); }
                bfl[nt * 64 + lane] = f;
            }
#pragma unroll 1
            for (int kb = 0; kb < 4; ++kb) { bf16x8 f;
#pragma unroll
                for (int j = 0; j < 8; ++j) { const int k = kb * 32 + kq * 8 + j, pp = k >> 1;
                    const float v = (k & 1) ? -P->in[I_ECIM][((size_t)dg * 16 + l15) * 64 + pp] : P->in[I_ECRE][((size_t)dg * 16 + l15) * 64 + pp];
                    f[j] = (short)f2bf(v); }
                cfl[kb * 64 + lane] = f; }
        }
        __syncthreads();
        const int bsub = wave & 1;
        auto uload = [&](int chunk) { const int row = row_of_step(chunk * CH + bsub * 16 + l15, b, dir);
            bf16x8 z = {0, 0, 0, 0, 0, 0, 0, 0}; if (kq < 2) z = *(const bf16x8*)(U + (size_t)row * 512 + g * 16 + kq * 8); unx = z; };
        auto bu_chunk = [&](int chunk) { LAS float* bw = bul + ((chunk & 1) * 2 + bsub) * (16 * 132);
#pragma unroll
            for (int nt = 0; nt < 8; ++nt) { f32x4 acc = {0.f, 0.f, 0.f, 0.f};
                acc = __builtin_amdgcn_mfma_f32_16x16x32_bf16(unx, bfl[nt * 64 + lane], acc, 0, 0, 0);
#pragma unroll
                for (int r = 0; r < 4; ++r) bw[(kq * 4 + r) * 132 + nt * 16 + l15] = acc[r]; } };
        auto s5_readout = [&](int chunk) { const LAS bf16_t* hb = hbl + (chunk & 1) * (32 * 136);
#pragma unroll
            for (int sub = 0; sub < 2; ++sub) { f32x4 accy = {0.f, 0.f, 0.f, 0.f};
#pragma unroll
                for (int kb = 0; kb < 4; ++kb) { const bf16x8 af = *(const LAS bf16x8*)(hb + (sub * 16 + l15) * 136 + kb * 32 + kq * 8);
                    accy = __builtin_amdgcn_mfma_f32_16x16x32_bf16(af, cfl[kb * 64 + lane], accy, 0, 0, 0); }
                const int row0 = row_of_step(chunk * CH + sub * 16 + kq * 4, b, dir); const int rstr = dir ? -512 : 512;
#pragma unroll
                for (int r = 0; r < 4; ++r) YSd[(ptrdiff_t)row0 * 512 + (ptrdiff_t)r * rstr + g * 16 + l15] = f2bf(accy[r]); } };
        const float* k_a = P->in[I_EKA] + (size_t)i * 512 + head * 64;
        struct SG { u32x4 r, k, v, kk, e, a; };
        SG g0, g1; g0.r = (u32x4){0u, 0u, 0u, 0u}; g0.k = g0.r; g0.v = g0.r; g0.kk = g0.r; g0.e = g0.r; g0.a = g0.r; g1 = g0;
        const int item0 = wave < 6 ? ((wave & 1) * 64 + lane) : (128 + lane), item1 = 192 + lane;
        const int sstp0 = item0 >> 3, sstp1 = item1 >> 3, oct = lane & 7;
        const bool st_a = (wave >= 4 && wave < 7), st_b = (wave == 6);
        f32x4 ka0 = {0.f, 0.f, 0.f, 0.f}, ka1 = ka0;
        if (tid >= 256) { ka0 = *(const f32x4*)(k_a + oct * 8); ka1 = *(const f32x4*)(k_a + oct * 8 + 4); }
        auto sload1 = [&](SG& q, int sstp, int chunk) {
            const int row = row_of_step(chunk * CH + sstp, b, dir); const size_t off = (size_t)row * 512 + head * 64 + oct * 8;
            q.r = *(const u32x4*)(R + off); q.k = *(const u32x4*)(KR + off); q.v = *(const u32x4*)(V + off); q.kk = *(const u32x4*)(KK + off);
            q.e = *(const u32x4*)(Ed + off); q.a = *(const u32x4*)(Ad + off); };
        auto sload = [&](int chunk) { if (st_a) sload1(g0, sstp0, chunk); if (st_b) sload1(g1, sstp1, chunk); };
        auto sconv1 = [&](const SG& q, int sstp, LAS float* buf) {
            const u32x4 gR = q.r, gK = q.k, gV = q.v, gKK = q.kk, gE = q.e, gA = q.a;
            LAS float* p = buf + sstp * SST + oct * 8;
            float krp = 0.f, brp = 0.f; f32x4 okk[2], ow[2], okd[2], obb[2], owr[2], ov[2];
#pragma unroll
            for (int h2 = 0; h2 < 2; ++h2) {
                const unsigned wR0 = h2 ? gR.z : gR.x, wR1 = h2 ? gR.w : gR.y, wK0 = h2 ? gK.z : gK.x, wK1 = h2 ? gK.w : gK.y, wV0 = h2 ? gV.z : gV.x, wV1 = h2 ? gV.w : gV.y;
                const unsigned wQ0 = h2 ? gKK.z : gKK.x, wQ1 = h2 ? gKK.w : gKK.y, wE0 = h2 ? gE.z : gE.x, wE1 = h2 ? gE.w : gE.y, wA0 = h2 ? gA.z : gA.x, wA1 = h2 ? gA.w : gA.y;
                const float r4[4] = {lo16(wR0), hi16(wR0), lo16(wR1), hi16(wR1)}, k4[4] = {lo16(wK0), hi16(wK0), lo16(wK1), hi16(wK1)};
                const float q4[4] = {lo16(wQ0), hi16(wQ0), lo16(wQ1), hi16(wQ1)}, e4[4] = {lo16(wE0), hi16(wE0), lo16(wE1), hi16(wE1)}, a4[4] = {lo16(wA0), hi16(wA0), lo16(wA1), hi16(wA1)};
                const f32x4 kav = h2 ? ka1 : ka0;
                ov[h2] = (f32x4){lo16(wV0), hi16(wV0), lo16(wV1), hi16(wV1)};
#pragma unroll
                for (int j = 0; j < 4; ++j) { const float w = __expf(-e4[j]), kd = k4[j] * (1.f + (a4[j] - 1.f) * kav[j]), bb = q4[j] * a4[j];
                    okk[h2][j] = q4[j]; ow[h2][j] = w; okd[h2][j] = kd; obb[h2][j] = bb; owr[h2][j] = w * r4[j]; krp += kd * r4[j]; brp += bb * r4[j]; }
            }
            krp += __shfl_xor(krp, 1); brp += __shfl_xor(brp, 1); krp += __shfl_xor(krp, 2); brp += __shfl_xor(brp, 2); krp += __shfl_xor(krp, 4); brp += __shfl_xor(brp, 4);
            *(LAS f32x4*)(p) = okk[0]; *(LAS f32x4*)(p + 4) = okk[1]; *(LAS f32x4*)(p + 64) = ow[0]; *(LAS f32x4*)(p + 68) = ow[1];
            *(LAS f32x4*)(p + 128) = okd[0]; *(LAS f32x4*)(p + 132) = okd[1]; *(LAS f32x4*)(p + 192) = obb[0]; *(LAS f32x4*)(p + 196) = obb[1];
            *(LAS f32x4*)(p + 256) = owr[0]; *(LAS f32x4*)(p + 260) = owr[1];
            if ((oct >> 1) == rq) { LAS float* pv = buf + sstp * SST + 320 + (oct & 1) * 8; *(LAS f32x4*)(pv) = ov[0]; *(LAS f32x4*)(pv + 4) = ov[1]; }
            if (oct == 0) { buf[sstp * SST + 336] = krp * 0.0625f; buf[sstp * SST + 337] = brp * 0.0625f; }
        };
        auto sconvert = [&](LAS float* buf) { if (st_a) sconv1(g0, sstp0, buf); if (st_b) sconv1(g1, sstp1, buf); };
        if (tid >= 256) { sload(0); sconvert(sbuf); sload(1); }
        if (wave == 4 || wave == 5) { uload(0); bu_chunk(0); uload(1); }
        __syncthreads();
        for (int c = 0; c < NCHUNK; ++c) {
            LAS float* buf = sbuf + (c & 1) * CH * SST;
            if (wave < 4) {
                __builtin_amdgcn_s_setprio(3);
                const int orow0 = row_of_step(c * CH, b, dir); const int ostr = dir ? -512 : 512;
                bf16_t* op = Od + (size_t)orow0 * 512 + head * 64 + rq * 16 + il;
                const LAS float* pb = buf;
                f32x4 nkk = *(const LAS f32x4*)(pb + cg4), nw = *(const LAS f32x4*)(pb + 64 + cg4), nkd = *(const LAS f32x4*)(pb + 128 + cg4),
                      nbb = *(const LAS f32x4*)(pb + 192 + cg4), nwr = *(const LAS f32x4*)(pb + 256 + cg4);
                float nv = pb[320 + il]; pg8::f32x2 nkb = *(const LAS pg8::f32x2*)(pb + 336);
#pragma unroll 1
                for (int hb = 0; hb < CH / 16; ++hb) {
                    float qv[16];
#pragma unroll
                    for (int s16 = 0; s16 < 16; ++s16) {
                        const f32x4 kk = nkk, w = nw, kd = nkd, bb = nbb, wr = nwr; const float v = nv, kr = nkb.x, br = nkb.y;
                        const LAS float* p = buf + (hb * 16 + s16 + 1) * SST;
                        nkk = *(const LAS f32x4*)(p + cg4); nw = *(const LAS f32x4*)(p + 64 + cg4); nkd = *(const LAS f32x4*)(p + 128 + cg4);
                        nbb = *(const LAS f32x4*)(p + 192 + cg4); nwr = *(const LAS f32x4*)(p + 256 + cg4); nv = p[320 + il]; nkb = *(const LAS pg8::f32x2*)(p + 336);
                        __builtin_amdgcn_sched_barrier(0);
                        typedef pg8::f32x2 v2;
                        const v2 kkA = {kk[0], kk[1]}, kkB = {kk[2], kk[3]}, wrA = {wr[0], wr[1]}, wrB = {wr[2], wr[3]};
                        v2 t1 = sA * kkA; t1 = __builtin_elementwise_fma(sB, kkB, t1);
                        v2 t2 = sA * wrA; t2 = __builtin_elementwise_fma(sB, wrB, t2);
                        float p1 = t1.x + t1.y; const float p2 = t2.x + t2.y;
                        p1 = red16(p1);
                        qv[s16] = p2 + (v * kr - p1 * br);
                        const v2 wA = {w[0], w[1]}, wB = {w[2], w[3]}, kdA = {kd[0], kd[1]}, kdB = {kd[2], kd[3]}, bbA = {bb[0], bb[1]}, bbB = {bb[2], bb[3]};
                        const v2 vv = {v, v}, pp = {p1, p1};
                        v2 uA = bbA * pp; uA = __builtin_elementwise_fma(kdA, vv, -uA); sA = __builtin_elementwise_fma(sA, wA, uA);
                        v2 uB = bbB * pp; uB = __builtin_elementwise_fma(kdB, vv, -uB); sB = __builtin_elementwise_fma(sB, wB, uB);
                        __builtin_amdgcn_sched_barrier(0);
                    }
                    const bool b3 = (lane & 8) != 0, b2 = (lane & 4) != 0, b1 = (lane & 2) != 0, b0 = (lane & 1) != 0;
                    float r8[8], r4[4], r2[2];
#pragma unroll
                    for (int j = 0; j < 8; ++j) { const float kp = b3 ? qv[j + 8] : qv[j], sd = b3 ? qv[j] : qv[j + 8]; r8[j] = kp + dpp_mov<0x140>(sd); }
#pragma unroll
                    for (int j = 0; j < 4; ++j) { const float kp = b2 ? r8[j + 4] : r8[j], sd = b2 ? r8[j] : r8[j + 4]; r4[j] = kp + dpp_mov<0x141>(sd); }
#pragma unroll
                    for (int j = 0; j < 2; ++j) { const float kp = b1 ? r4[j + 2] : r4[j], sd = b1 ? r4[j] : r4[j + 2]; r2[j] = kp + dpp_mov<0x1B>(sd); }
                    const float keep = (b0 ? r2[1] : r2[0]) + dpp_mov<0xB1>(b0 ? r2[0] : r2[1]);
                    op[(ptrdiff_t)(hb * 16 + (lane & 15)) * ostr] = f2bf(keep);
                }
                __builtin_amdgcn_s_setprio(0);
            } else {
                if (c + 1 < NCHUNK) sconvert(sbuf + ((c + 1) & 1) * CH * SST);
                if (c + 2 < NCHUNK) sload(c + 2);
            }
            if (wave == 4 || wave == 5) { if (c + 1 < NCHUNK) bu_chunk(c + 1); if (c + 2 < NCHUNK) uload(c + 2); }
            else if (wave == 7) {
                const LAS float* br_ = bul + (c & 1) * 2 * (16 * 132); LAS unsigned* hw = (LAS unsigned*)(hbl + (c & 1) * (32 * 136));
#pragma unroll 8
                for (int tl = 0; tl < 32; ++tl) { const pg8::f32x2 bv = *(const LAS pg8::f32x2*)(br_ + tl * 132 + 2 * lane);
                    const float nr = are * hre - aim * him + bv.x, ni = are * him + aim * hre + bv.y; hre = nr; him = ni;
                    hw[tl * 68 + lane] = cvt_pk_bf16(hre, him); }
                if (c > 0) s5_readout(c - 1);
            }
            __syncthreads();
        }
        if (wave == 7) s5_readout(NCHUNK - 1);
    }
}
__device__ __forceinline__ void read_phase(PP P, int i, int nrows) {
    const int lane = tidx() & 63, gw = bidx() * 8 + (tidx() >> 6), NGW = gridDim.x * 8;
    char* big = P->ws + OFF_BIG;
    const bf16_t* R = (const bf16_t*)(big + B_RVK); const bf16_t* KR = R + SE; const bf16_t* V = R + 2 * SE;
    const bf16_t* EA = (const bf16_t*)(big + B_PR); const bf16_t* Af = EA + 2 * SE; const bf16_t* Ab = EA + 3 * SE; const bf16_t* G = (const bf16_t*)(big + B_G);
    const bf16_t* U = (const bf16_t*)(big + B_U); const bf16_t* Of = (const bf16_t*)(big + B_O); const bf16_t* Ob = Of + SE;
    bf16_t* YSf = (bf16_t*)(big + B_YS); const bf16_t* YSb = YSf + SE; bf16_t* YCAT = (bf16_t*)(P->ws + OFF_H);
    const float* k_a = P->in[I_EKA] + (size_t)i * 512; const float* r_k = P->in[I_ERK] + (size_t)i * 512;
    const float* gn_g = P->in[I_EGNG] + (size_t)i * 512; const float* gn_b = P->in[I_EGNB] + (size_t)i * 512; const float* dsk = P->in[I_ED] + (size_t)i * 512;
    for (int row = gw; row < nrows; row += NGW) {
        unsigned short ld[8][9];
#pragma unroll
        for (int h = 0; h < 8; ++h) { const size_t off = (size_t)row * 512 + h * 64 + lane;
            ld[h][0] = Of[off]; ld[h][1] = Ob[off]; ld[h][2] = R[off]; ld[h][3] = KR[off]; ld[h][4] = V[off]; ld[h][5] = Af[off]; ld[h][6] = Ab[off]; ld[h][7] = G[off]; }
#pragma unroll
        for (int h = 0; h < 8; ++h) { const int c = h * 64 + lane;
            const float o = bf2f(ld[h][0]) + bf2f(ld[h][1]);
            const float mean = wave_sum(o) * (1.f / 64.f); const float dlt = o - mean; const float var = wave_sum(dlt * dlt) * (1.f / 64.f);
            const float on = dlt * rsqrtf(var + 64e-5f);
            const float r = bf2f(ld[h][2]), kraw = bf2f(ld[h][3]), v = bf2f(ld[h][4]), af = bf2f(ld[h][5]), ab = bf2f(ld[h][6]), gg = bf2f(ld[h][7]);
            const float ka = k_a[c]; const float kds = kraw * ((1.f + (af - 1.f) * ka) + (1.f + (ab - 1.f) * ka));
            const float dot = wave_sum(r * kds * r_k[c]);
            YCAT[(size_t)row * 1024 + c] = f2bf((on * gn_g[c] + gn_b[c] + dot * v) * gg);
        }
        { const int c0 = lane * 8; const size_t off = (size_t)row * 512 + c0;
          const u32x4 yf = *(const u32x4*)(YSf + off), yb = *(const u32x4*)(YSb + off), uu = *(const u32x4*)(U + off);
          float y[8] = {lo16(yf.x) + lo16(yb.x), hi16(yf.x) + hi16(yb.x), lo16(yf.y) + lo16(yb.y), hi16(yf.y) + hi16(yb.y),
                        lo16(yf.z) + lo16(yb.z), hi16(yf.z) + hi16(yb.z), lo16(yf.w) + lo16(yb.w), hi16(yf.w) + hi16(yb.w)};
          const float uv[8] = {lo16(uu.x), hi16(uu.x), lo16(uu.y), hi16(uu.y), lo16(uu.z), hi16(uu.z), lo16(uu.w), hi16(uu.w)};
#pragma unroll
          for (int j = 0; j < 8; ++j) { const float t = y[j] + dsk[c0 + j] * uv[j]; y[j] = 0.5f * t * (1.f + tanh_fast(0.7978845608f * (t + 0.044715f * t * t * t))); }
          u32x4 w; w.x = pk2(y[0], y[1]); w.y = pk2(y[2], y[3]); w.z = pk2(y[4], y[5]); w.w = pk2(y[6], y[7]);
          *(u32x4*)(YSf + off) = w; }
    }
}

constexpr int FN = 16384;
typedef float cf2 __attribute__((ext_vector_type(2)));
__device__ __forceinline__ cf2 mk2(float a, float b) { cf2 r; r.x = a; r.y = b; return r; }
__device__ __forceinline__ cf2 cadd(cf2 a, cf2 b) { return a + b; }
__device__ __forceinline__ cf2 csub(cf2 a, cf2 b) { return a - b; }
__device__ __forceinline__ cf2 cmul(cf2 a, cf2 b) { const cf2 br = mk2(-b.y, b.x); return __builtin_shufflevector(a, a, 0, 0) * b + __builtin_shufflevector(a, a, 1, 1) * br; }
__device__ __forceinline__ cf2 cmulc(cf2 a, cf2 b) { const cf2 bc = mk2(b.x, -b.y), bs = mk2(b.y, b.x); return __builtin_shufflevector(a, a, 0, 0) * bc + __builtin_shufflevector(a, a, 1, 1) * bs; }
__device__ __forceinline__ int SW(int i) { return i; }
__device__ __forceinline__ cf2 twid(int m) { const float x = (float)m * (1.0f / 16384.0f); return mk2(__builtin_amdgcn_cosf(x), -__builtin_amdgcn_sinf(x)); }
__device__ __forceinline__ cf2 rot_mi(cf2 z) { return mk2(z.y, -z.x); }
__device__ __forceinline__ cf2 rot_pi(cf2 z) { return mk2(-z.y, z.x); }
template <bool ZH> __device__ __forceinline__ void fft_fwd_pass_t(LAS cf2* S, int pass) {
    const int tid = tidx(); const float c = 0.70710678118654752f;
    if (pass < 4) {
        const int s = 3 * pass, el = 11 - s, e = 1 << el;
#pragma unroll 2
        for (int k = 0; k < 4; ++k) {
            const int gi = tid + 512 * k, grp = gi >> el, pos = gi & (e - 1), i0 = (grp << (el + 3)) + pos;
            cf2 x[8];
#pragma unroll
            for (int j = 0; j < 8; ++j) x[j] = (ZH && j >= 4) ? mk2(0.f, 0.f) : S[SW(i0 + j * e)];
            const cf2 w1 = twid(pos << s), w2 = cmul(w1, w1), w4 = cmul(w2, w2);
            const cf2 a0 = x[0] + x[4], a1 = x[1] + x[5], a2 = x[2] + x[6], a3 = x[3] + x[7];
            const cf2 d0 = x[0] - x[4], d1 = x[1] - x[5], d2 = x[2] - x[6], d3 = x[3] - x[7];
            const cf2 b0 = cmul(d0, w1), b1 = cmul(mk2((d1.x + d1.y) * c, (d1.y - d1.x) * c), w1), b2 = cmul(rot_mi(d2), w1), b3 = cmul(mk2((d3.y - d3.x) * c, (-d3.y - d3.x) * c), w1);
            const cf2 c0 = a0 + a2, c2 = cmul(a0 - a2, w2), c1 = a1 + a3, c3 = cmul(rot_mi(a1 - a3), w2);
            const cf2 g0 = b0 + b2, g2 = cmul(b0 - b2, w2), g1 = b1 + b3, g3 = cmul(rot_mi(b1 - b3), w2);
            S[SW(i0)] = c0 + c1; S[SW(i0 + e)] = cmul(c0 - c1, w4); S[SW(i0 + 2 * e)] = c2 + c3; S[SW(i0 + 3 * e)] = cmul(c2 - c3, w4);
            S[SW(i0 + 4 * e)] = g0 + g1; S[SW(i0 + 5 * e)] = cmul(g0 - g1, w4); S[SW(i0 + 6 * e)] = g2 + g3; S[SW(i0 + 7 * e)] = cmul(g2 - g3, w4);
        }
    } else {
#pragma unroll 4
        for (int k = 0; k < 8; ++k) {
            const int i0 = 4 * (tid + 512 * k);
            const cf2 x0 = S[SW(i0)], x1 = S[SW(i0 + 1)], x2 = S[SW(i0 + 2)], x3 = S[SW(i0 + 3)];
            const cf2 t0 = x0 + x2, t2 = x0 - x2, t1 = x1 + x3, t3 = rot_mi(x1 - x3);
            S[SW(i0)] = t0 + t1; S[SW(i0 + 1)] = t0 - t1; S[SW(i0 + 2)] = t2 + t3; S[SW(i0 + 3)] = t2 - t3;
        }
    }
}
template <bool LOW, bool KM> __device__ __forceinline__ void fft_inv_pass_t(LAS cf2* S, int pass, const cf2* Kp) {
    const int tid = tidx(); const float c = 0.70710678118654752f;
    if (pass < 4) {
        const int s = 3 * pass, el = 11 - s, e = 1 << el;
#pragma unroll 2
        for (int k = 0; k < 4; ++k) {
            const int gi = tid + 512 * k, grp = gi >> el, pos = gi & (e - 1), i0 = (grp << (el + 3)) + pos;
            cf2 y[8];
#pragma unroll
            for (int j = 0; j < 8; ++j) y[j] = S[SW(i0 + j * e)];
            const cf2 w1 = twid(pos << s), w2 = cmul(w1, w1), w4 = cmul(w2, w2);
            const cf2 q1 = cmulc(y[1], w4), q3 = cmulc(y[3], w4), q5 = cmulc(y[5], w4), q7 = cmulc(y[7], w4);
            const cf2 c0 = y[0] + q1, c1 = y[0] - q1, c2 = y[2] + q3, c3 = y[2] - q3, g0 = y[4] + q5, g1 = y[4] - q5, g2 = y[6] + q7, g3 = y[6] - q7;
            const cf2 r2 = cmulc(c2, w2), r3 = rot_pi(cmulc(c3, w2)), h2 = cmulc(g2, w2), h3 = rot_pi(cmulc(g3, w2));
            const cf2 a0 = c0 + r2, a2 = c0 - r2, a1 = c1 + r3, a3 = c1 - r3, b0 = g0 + h2, b2 = g0 - h2, b1 = g1 + h3, b3 = g1 - h3;
            const cf2 v0 = cmulc(b0, w1), v1 = cmulc(b1, w1), v2 = cmulc(b2, w1), v3 = cmulc(b3, w1);
            const cf2 u0 = v0, u1 = mk2((v1.x - v1.y) * c, (v1.x + v1.y) * c), u2 = rot_pi(v2), u3 = mk2((-v3.x - v3.y) * c, (v3.x - v3.y) * c);
            S[SW(i0)] = a0 + u0; S[SW(i0 + e)] = a1 + u1; S[SW(i0 + 2 * e)] = a2 + u2; S[SW(i0 + 3 * e)] = a3 + u3;
            if (!LOW) { S[SW(i0 + 4 * e)] = a0 - u0; S[SW(i0 + 5 * e)] = a1 - u1; S[SW(i0 + 6 * e)] = a2 - u2; S[SW(i0 + 7 * e)] = a3 - u3; }
        }
    } else {
#pragma unroll 1
        for (int hh = 0; hh < 2; ++hh) {
            cf2 kv[4][4];
            if (KM) {
#pragma unroll
                for (int k = 0; k < 4; ++k) { const int i0 = 4 * (tid + 512 * (hh * 4 + k));
#pragma unroll
                    for (int j = 0; j < 4; ++j) kv[k][j] = Kp[i0 + j]; } }
#pragma unroll
            for (int k = 0; k < 4; ++k) {
                const int i0 = 4 * (tid + 512 * (hh * 4 + k));
                cf2 y0 = S[SW(i0)], y1 = S[SW(i0 + 1)], y2 = S[SW(i0 + 2)], y3 = S[SW(i0 + 3)];
                if (KM) { y0 = cmul(y0, kv[k][0]); y1 = cmul(y1, kv[k][1]); y2 = cmul(y2, kv[k][2]); y3 = cmul(y3, kv[k][3]); }
                const cf2 t0 = y0 + y1, t1 = y0 - y1, t2 = y2 + y3, t3 = rot_pi(y2 - y3);
                S[SW(i0)] = t0 + t2; S[SW(i0 + 2)] = t0 - t2; S[SW(i0 + 1)] = t1 + t3; S[SW(i0 + 3)] = t1 - t3;
            }
        }
    }
}
__device__ __forceinline__ void fft_fwd_pass(LAS cf2* S, int pass) { fft_fwd_pass_t<false>(S, pass); }
__device__ __forceinline__ void fft_inv_pass(LAS cf2* S, int pass) { fft_inv_pass_t<false, false>(S, pass, nullptr); }
#ifndef FFT_HOST
__device__ __forceinline__ void fft_fwd(LAS cf2* S) {
#pragma unroll 1
    for (int p = 0; p < 5; ++p) { fft_fwd_pass_t<false>(S, p); __syncthreads(); }
}
__device__ __forceinline__ void fft_inv(LAS cf2* S) {
#pragma unroll 1
    for (int p = 4; p >= 0; --p) { fft_inv_pass_t<false, false>(S, p, nullptr); __syncthreads(); }
}
__device__ __forceinline__ void fft_fwd_zh(LAS cf2* S) {
    fft_fwd_pass_t<true>(S, 0); __syncthreads();
#pragma unroll 1
    for (int p = 1; p < 5; ++p) { fft_fwd_pass_t<false>(S, p); __syncthreads(); }
}
__device__ __forceinline__ void fft_inv_km(LAS cf2* S, const cf2* Kp) {
    fft_inv_pass_t<false, true>(S, 4, Kp); __syncthreads();
#pragma unroll 1
    for (int p = 3; p >= 1; --p) { fft_inv_pass_t<false, false>(S, p, nullptr); __syncthreads(); }
    fft_inv_pass_t<true, false>(S, 0, nullptr); __syncthreads();
}
#endif
__device__ __forceinline__ float block_sum(float v, LAS float* red) {
    v = wave_sum(v);
    __syncthreads();
    if ((tidx() & 63) == 0) red[tidx() >> 6] = v;
    __syncthreads();
    float s = 0.f;
#pragma unroll
    for (int w = 0; w < 8; ++w) s += red[w];
    return s;
}
__device__ __forceinline__ float hy_delta(int c) { const float mn = -3.0701134573253946f, mx = -15.350567286626973f; return fabsf(mn + (float)c * ((mx - mn) / 1023.0f)); }
__device__ __forceinline__ void hyena_phase(PP P, int io, bool with_ctx, LAS unsigned char* ldsb) {
    const int tid = tidx();
    LAS cf2* S = (LAS cf2*)ldsb; LAS float* ex = (LAS float*)(ldsb + 131072); LAS float* fwc = ex; LAS float* red = ex + 256;
    char* big = P->ws + OFF_BIG;
    const bf16_t* PT = (const bf16_t*)(big + B_PT); bf16_t* ZT = (bf16_t*)(big + B_ZT);
    cf2* KS = (cf2*)(big + B_KS) + (size_t)bidx() * (2 * FN + 8192);
    const bf16_t* hdnb = (const bf16_t*)(P->ws + OFF_HDNB) + (size_t)io * 8192 * 64; const float* hdnc = (const float*)(P->ws + OFF_HDNC);
    const float* fw4 = P->in[I_OFW4] + (size_t)io * 64 * 4096;
    const float* cw = P->in[I_OCW] + (size_t)io * 3 * 3072; const float* cb = P->in[I_OCB] + (size_t)io * 3072; const float* bias = P->in[I_OBIAS] + (size_t)io * 2 * 1024;
    for (int c = bidx(); c < 1024; c += gridDim.x) {
        __syncthreads();
        if (tid < 256) { const int q = tid >> 6, k = tid & 63; fwc[k * 4 + q] = fw4[(size_t)k * 4096 + (q >> 1) * 2048 + (q & 1) * 1024 + c]; }
        __syncthreads();
        const float delta = hy_delta(c);
        float ss0, ss1;
        { const int lane = tid & 63, wave = tid >> 6, kq = lane >> 4, l15 = lane & 15;
          bf16x8 bfr[2];
#pragma unroll
          for (int kb = 0; kb < 2; ++kb) { bf16x8 f;
#pragma unroll
              for (int j = 0; j < 8; ++j) f[j] = (short)(l15 < 4 ? f2bf(fwc[(kb * 32 + kq * 8 + j) * 4 + l15]) : 0);
              bfr[kb] = f; }
          LAS float* Sf = (LAS float*)S; float ssq = 0.f;
          const int n = l15, so = n >> 1;
#pragma unroll 4
          for (int it = 0; it < 64; ++it) { const int tb = (wave + 8 * it) * 16;
              const bf16_t* hp = hdnb + (size_t)(tb + l15) * 64 + kq * 8;
              const bf16x8 a0 = *(const bf16x8*)(hp), a1 = *(const bf16x8*)(hp + 32);
              f32x4 acc = {0.f, 0.f, 0.f, 0.f};
              acc = __builtin_amdgcn_mfma_f32_16x16x32_bf16(a0, bfr[0], acc, 0, 0, 0);
              acc = __builtin_amdgcn_mfma_f32_16x16x32_bf16(a1, bfr[1], acc, 0, 0, 0);
              if (n < 4) {
#pragma unroll
                  for (int r = 0; r < 4; ++r) { const int t = tb + kq * 4 + r; const float f = acc[r] * __expf(-((float)t * (1.0f / 8191.0f)) * delta);
                      if ((n & 1) == 0) { Sf[2 * SW(t) + so] = f; ssq += f * f; }
                      else if (t >= 1) { Sf[2 * SW(FN - t) + so] = f; ssq += f * f; } } }
          }
          if (tid == 0) S[SW(8192)] = mk2(0.f, 0.f);
          ss0 = block_sum(n < 2 ? ssq : 0.f, red); ss1 = block_sum((n == 2 || n == 3) ? ssq : 0.f, red);
        }
        const float sc0 = rsqrtf(ss0 + 1e-6f) * (1.0f / FN), sc1 = rsqrtf(ss1 + 1e-6f) * (1.0f / FN);
        __syncthreads();
#ifdef FFT_REP
#pragma unroll 1
        for (int rep = 0; rep < FFT_REP; ++rep) { fft_fwd(S); fft_inv(S);
#pragma unroll 4
            for (int k = 0; k < 32; ++k) { const int j = tid + 512 * k; S[SW(j)] = S[SW(j)] * (1.0f / 16384.0f); }
            __syncthreads(); }
#endif
        fft_fwd(S);
#pragma unroll 1
        for (int k = 0; k < 32; ++k) { const int j = tid + 512 * k; const int kf = (int)(__brev((unsigned)j) >> 18); const int jp = (int)(__brev((unsigned)((FN - kf) & (FN - 1))) >> 18);
            const cf2 F = S[SW(j)], Fp = S[SW(jp)];
            KS[j] = mk2(0.5f * (F.x + Fp.x) * sc0, 0.5f * (F.y - Fp.y) * sc0);
            KS[FN + j] = mk2(0.5f * (F.y + Fp.y) * sc1, -0.5f * (F.x - Fp.x) * sc1); }
        __syncthreads();
        const float w00 = cw[c], w01 = cw[3072 + c], w02 = cw[6144 + c], b0 = cb[c];
        const float w10 = cw[1024 + c], w11 = cw[3072 + 1024 + c], w12 = cw[6144 + 1024 + c], b1 = cb[1024 + c];
        const float w20 = cw[2048 + c], w21 = cw[3072 + 2048 + c], w22 = cw[6144 + 2048 + c], b2 = cb[2048 + c];
        const float bs0 = bias[c], bs1 = bias[1024 + c];
        auto sconv = [&](const bf16_t* rowp, int t, int L, float wa, float wb, float wc, float bb) -> float {
            const float pm = t > 0 ? bf2f(rowp[t - 1]) : 0.f, pc = bf2f(rowp[t]), pp = t < L - 1 ? bf2f(rowp[t + 1]) : 0.f;
            return wa * pm + wb * pc + wc * pp + bb; };
        struct Ld8 { u32x4 v; float pm, pp; };
        auto ld8 = [&](const bf16_t* rowp, int t0) -> Ld8 { Ld8 r; r.v = *(const u32x4*)(rowp + t0);
            r.pm = t0 > 0 ? bf2f(rowp[t0 - 1]) : 0.f; r.pp = (t0 + 8 < SEQ) ? bf2f(rowp[t0 + 8]) : 0.f; return r; };
        auto sc8 = [&](const Ld8& L, float wa, float wb, float wc, float bb, float (&o)[8]) {
            const float x[10] = {L.pm, lo16(L.v.x), hi16(L.v.x), lo16(L.v.y), hi16(L.v.y), lo16(L.v.z), hi16(L.v.z), lo16(L.v.w), hi16(L.v.w), L.pp};
#pragma unroll
            for (int e = 0; e < 8; ++e) o[e] = wa * x[e] + wb * x[e + 1] + wc * x[e + 2] + bb; };
        auto kmul = [&](const cf2* Kp) {
#pragma unroll 1
            for (int hh = 0; hh < 2; ++hh) {
                u32x4 kv[8];
#pragma unroll
                for (int k = 0; k < 8; ++k) kv[k] = *(const u32x4*)(Kp + 2 * (tid + 512 * (hh * 8 + k)));
#pragma unroll
                for (int k = 0; k < 8; ++k) { LAS f32x4* sp = (LAS f32x4*)(S + SW(2 * (tid + 512 * (hh * 8 + k)))); const f32x4 sv = *sp;
                    const float k0x = __uint_as_float(kv[k].x), k0y = __uint_as_float(kv[k].y), k1x = __uint_as_float(kv[k].z), k1y = __uint_as_float(kv[k].w);
                    *sp = (f32x4){sv[0] * k0x - sv[1] * k0y, sv[0] * k0y + sv[1] * k0x, sv[2] * k1x - sv[3] * k1y, sv[2] * k1y + sv[3] * k1x}; } } };
#pragma unroll 1
        for (int pair = 0; pair < 2; ++pair) {
            const bf16_t* p0a = PT + (size_t)c * TT + (size_t)(2 * pair) * SEQ; const bf16_t* p0b = p0a + SEQ;
            const bf16_t* p1a = p0a + (size_t)1024 * TT; const bf16_t* p1b = p1a + SEQ; const bf16_t* p2a = p0a + (size_t)2048 * TT; const bf16_t* p2b = p2a + SEQ;
            cf2* Z1 = KS + 2 * FN;
            { Ld8 la[2], lb[2];
#pragma unroll
              for (int h = 0; h < 2; ++h) { const int t0 = 8 * (tid + 512 * h); la[h] = ld8(p0a, t0); lb[h] = ld8(p0b, t0); }
#pragma unroll
              for (int h = 0; h < 2; ++h) { const int t0 = 8 * (tid + 512 * h); float za[8], zb[8];
                  sc8(la[h], w00, w01, w02, b0, za); sc8(lb[h], w00, w01, w02, b0, zb);
#pragma unroll
                  for (int e = 0; e < 4; ++e) { *(LAS f32x4*)(S + SW(t0 + 2 * e)) = (f32x4){za[2 * e], zb[2 * e], za[2 * e + 1], zb[2 * e + 1]}; } } }
            __syncthreads();
            fft_fwd_zh(S);
            fft_inv_km(S, KS);
            { Ld8 la[2], lb[2], ga[2], gb[2];
#pragma unroll
              for (int h = 0; h < 2; ++h) { const int t0 = 8 * (tid + 512 * h); la[h] = ld8(p0a, t0); lb[h] = ld8(p0b, t0); ga[h] = ld8(p1a, t0); gb[h] = ld8(p1b, t0); }
#pragma unroll
              for (int h = 0; h < 2; ++h) { const int t0 = 8 * (tid + 512 * h); float za[8], zb[8], g1a[8], g1b[8];
                  sc8(la[h], w00, w01, w02, b0, za); sc8(lb[h], w00, w01, w02, b0, zb); sc8(ga[h], w10, w11, w12, b1, g1a); sc8(gb[h], w10, w11, w12, b1, g1b);
#pragma unroll
                  for (int e = 0; e < 4; ++e) { const f32x4 cv = *(const LAS f32x4*)(S + SW(t0 + 2 * e));
                      const f32x4 z = {g1a[2 * e] * (cv[0] + bs0 * za[2 * e]), g1b[2 * e] * (cv[1] + bs0 * zb[2 * e]),
                                       g1a[2 * e + 1] * (cv[2] + bs0 * za[2 * e + 1]), g1b[2 * e + 1] * (cv[3] + bs0 * zb[2 * e + 1])};
                      *(f32x4*)(Z1 + t0 + 2 * e) = z; *(LAS f32x4*)(S + SW(t0 + 2 * e)) = z; } } }
            __syncthreads();
            fft_fwd_zh(S);
            fft_inv_km(S, KS + FN);
            bf16_t* za_o = ZT + (size_t)c * TT + (size_t)(2 * pair) * SEQ; bf16_t* zb_o = za_o + SEQ;
            { Ld8 ga[2], gb[2]; f32x4 zz[2][4];
#pragma unroll
              for (int h = 0; h < 2; ++h) { const int t0 = 8 * (tid + 512 * h); ga[h] = ld8(p2a, t0); gb[h] = ld8(p2b, t0);
#pragma unroll
                  for (int e = 0; e < 4; ++e) zz[h][e] = *(const f32x4*)(Z1 + t0 + 2 * e); }
#pragma unroll
              for (int h = 0; h < 2; ++h) { const int t0 = 8 * (tid + 512 * h); float g2a[8], g2b[8], oa[8], ob[8];
                  sc8(ga[h], w20, w21, w22, b2, g2a); sc8(gb[h], w20, w21, w22, b2, g2b);
#pragma unroll
                  for (int e = 0; e < 4; ++e) { const f32x4 cv = *(const LAS f32x4*)(S + SW(t0 + 2 * e)); const f32x4 z1 = zz[h][e];
                      oa[2 * e] = g2a[2 * e] * (cv[0] + bs1 * z1[0]); ob[2 * e] = g2b[2 * e] * (cv[1] + bs1 * z1[1]);
                      oa[2 * e + 1] = g2a[2 * e + 1] * (cv[2] + bs1 * z1[2]); ob[2 * e + 1] = g2b[2 * e + 1] * (cv[3] + bs1 * z1[3]); }
                  u32x4 wa_, wb_; wa_.x = pk2(oa[0], oa[1]); wa_.y = pk2(oa[2], oa[3]); wa_.z = pk2(oa[4], oa[5]); wa_.w = pk2(oa[6], oa[7]);
                  wb_.x = pk2(ob[0], ob[1]); wb_.y = pk2(ob[2], ob[3]); wb_.z = pk2(ob[4], ob[5]); wb_.w = pk2(ob[6], ob[7]);
                  *(u32x4*)(za_o + t0) = wa_; *(u32x4*)(zb_o + t0) = wb_; } }
            __syncthreads();
        }
        if (with_ctx) {
            LAS float* kl = (LAS float*)ldsb;
            LAS float* zc = kl + 1024;
            float s0 = 0.f, s1 = 0.f; float f0 = 0.f, f1 = 0.f, f2 = 0.f, f3 = 0.f;
            if (tid < 256) { const int t = tid; const float* hr = hdnc + (size_t)t * 64;
                for (int k = 0; k < 64; ++k) { const float hv = hr[k]; f0 += hv * fwc[4 * k]; f1 += hv * fwc[4 * k + 1]; f2 += hv * fwc[4 * k + 2]; f3 += hv * fwc[4 * k + 3]; }
                const float dec = expf(-((float)t / 255.0f) * delta); f0 *= dec; f1 *= dec; f2 *= dec; f3 *= dec;
                s0 = f0 * f0 + (t >= 1 ? f1 * f1 : 0.f); s1 = f2 * f2 + (t >= 1 ? f3 * f3 : 0.f); }
            const float c0s = rsqrtf(block_sum(s0, red) + 1e-6f), c1s = rsqrtf(block_sum(s1, red) + 1e-6f);
            if (tid < 256) { const int t = tid; kl[256 + t] = f0 * c0s; kl[512 + 256 + t] = f2 * c1s; if (t >= 1) { kl[256 - t] = f1 * c0s; kl[512 + 256 - t] = f3 * c1s; } }
            float zv[2], gv1[2], gv2[2];
#pragma unroll
            for (int e = 0; e < 2; ++e) { const int idx = tid + 512 * e, bb = idx >> 8, t = idx & 255;
                const bf16_t* rp = PT + (size_t)c * TT + TLAT + bb * CTXL;
                zv[e] = sconv(rp, t, CTXL, w00, w01, w02, b0); gv1[e] = sconv(rp + (size_t)1024 * TT, t, CTXL, w10, w11, w12, b1); gv2[e] = sconv(rp + (size_t)2048 * TT, t, CTXL, w20, w21, w22, b2);
                zc[idx] = zv[e]; }
            __syncthreads();
#pragma unroll 1
            for (int n = 0; n < 2; ++n) {
                float cvv[2];
#pragma unroll
                for (int e = 0; e < 2; ++e) { const int idx = tid + 512 * e, bb = idx >> 8, t = idx & 255; float a = 0.f;
                    for (int s = 0; s < 256; ++s) a += zc[bb * 256 + s] * kl[n * 512 + 256 + t - s];
                    cvv[e] = a; }
                __syncthreads();
#pragma unroll
                for (int e = 0; e < 2; ++e) { const int idx = tid + 512 * e;
                    zv[e] = (n == 0 ? gv1[e] : gv2[e]) * (cvv[e] + (n == 0 ? bs0 : bs1) * zv[e]); zc[idx] = zv[e]; }
                __syncthreads();
            }
#pragma unroll
            for (int e = 0; e < 2; ++e) { const int idx = tid + 512 * e; ZT[(size_t)c * TT + TLAT + idx] = f2bf(zv[e]); }
            __syncthreads();
        }
    }
}
__device__ __forceinline__ void tr_phase(PP P, int ntok, LAS unsigned char* ldsb) {
    const int tid = tidx(); LAS bf16_t* tile = (LAS bf16_t*)ldsb;
    const bf16_t* ZT = (const bf16_t*)(P->ws + OFF_BIG + B_ZT); bf16_t* A2 = (bf16_t*)(P->ws + OFF_H);
    const int ntt = ntok / 256;
    for (int it = bidx(); it < 16 * ntt; it += gridDim.x) {
        const int ct = it & 15, tt = it >> 4, c0 = ct * 64, t0 = tt * 256;
        u32x4 v[4];
        { const int ch = tid >> 3, ck = tid & 7;
#pragma unroll
          for (int q = 0; q < 4; ++q) v[q] = *(const u32x4*)(ZT + (size_t)(c0 + ch) * TT + t0 + q * 64 + ck * 8);
#pragma unroll
          for (int q = 0; q < 4; ++q) *(LAS u32x4*)(tile + q * (64 * 72) + ch * 72 + ck * 8) = v[q]; }
        __syncthreads();
        { const int tk = tid >> 3, ck = tid & 7;
#pragma unroll
          for (int q = 0; q < 4; ++q) { unsigned short e[8];
#pragma unroll
              for (int j = 0; j < 8; ++j) e[j] = tile[q * (64 * 72) + (ck * 8 + j) * 72 + tk];
              u32x4 w; w.x = e[0] | ((unsigned)e[1] << 16); w.y = e[2] | ((unsigned)e[3] << 16); w.z = e[4] | ((unsigned)e[5] << 16); w.w = e[6] | ((unsigned)e[7] << 16);
              *(u32x4*)(A2 + (size_t)(t0 + q * 64 + tk) * 1024 + c0 + ck * 8) = w; } }
        __syncthreads();
    }
}
__device__ __forceinline__ void final_phase(PP P) {
    const int lane = tidx() & 63, gw = bidx() * 8 + (tidx() >> 6), NGW = gridDim.x * 8;
    const float* gain = P->in[I_FINALG];
    for (int row0 = gw; row0 < TLAT; row0 += 4 * NGW) {
        f32x4 v[4][4];
#pragma unroll
        for (int q = 0; q < 4; ++q) { const int row = row0 + q * NGW;
            if (row < TLAT) {
#pragma unroll
                for (int j = 0; j < 4; ++j) v[q][j] = *(const f32x4*)(P->out + (size_t)row * D + 4 * lane + 256 * j); } }
#pragma unroll
        for (int q = 0; q < 4; ++q) { const int row = row0 + q * NGW; if (row >= TLAT) continue;
            float s = 0.f;
#pragma unroll
            for (int j = 0; j < 4; ++j) s += (v[q][j][0] * v[q][j][0] + v[q][j][1] * v[q][j][1]) + (v[q][j][2] * v[q][j][2] + v[q][j][3] * v[q][j][3]);
            const float rstd = rsqrtf(wave_sum(s) * (1.f / D) + 1e-6f);
#pragma unroll
            for (int j = 0; j < 4; ++j) { const int c = 4 * lane + 256 * j; *(f32x4*)(P->out + (size_t)row * D + c) = v[q][j] * rstd * *(const f32x4*)(gain + c); } }
    }
}
#ifndef DUP_MASK
#define DUP_MASK 0u
#endif
#ifndef NOP_COUNT
#define NOP_COUNT 0
#endif
#ifndef PHASE_MASK
#define PHASE_MASK 0xFFFFFFFFu
#endif
#define EN(t) if (!((PHASE_MASK >> (t)) & 1u)) break;
__global__ void __launch_bounds__(512, 2) mega(const Params Pv, int p0, int p1) {
    PP P = (PP)__builtin_amdgcn_kernarg_segment_ptr();
    extern __shared__ __attribute__((aligned(16))) unsigned char dyn_lds[];
    LAS unsigned char* lds = (LAS unsigned char*)dyn_lds;
    cg::grid_group grid = cg::this_grid();
    volatile LAS unsigned* xst = (volatile LAS unsigned*)(lds + LDS_BYTES - 16);
    if (threadIdx.x == 0) { xst[0] = 0u; xst[1] = 0u; }
    __syncthreads();
    XcdBarrier xb = xcd_barrier_post((unsigned*)Pv.ws, xst);
    for (int ip = p0; ip < p1; ++ip) {
        asm volatile("" : "+s"(P) : "s"(ip));
    char* ws = P->ws;
        float* XC = (float*)(ws + OFF_XC); const float* mods = (const float*)(ws + OFF_MODS);
        bf16_t* H = (bf16_t*)(ws + OFF_H); bf16_t* ACT = (bf16_t*)(ws + OFF_BIG);
        bf16_t* W1 = (bf16_t*)(ws + OFF_W1); bf16_t* W2 = (bf16_t*)(ws + OFF_W2); char* WM = ws + OFF_WMIX; char* big = ws + OFF_BIG;
        Phase ph; ph.type = P->ph[ip].type; ph.l = P->ph[ip].l; ph.a = P->ph[ip].a; ph.b = P->ph[ip].b & 0xff; const int nkpend = (P->ph[ip].b >> 12) & 0xff; float* PART = (float*)(big + (size_t)200 * 1024 * 1024); const bool dry = (P->ph[ip].b & 0x100) != 0; const int l = ph.l, i = l >> 1;
        float* dry_out = (float*)(big + (ph.type == PH_F2 ? (size_t)200 * 1024 * 1024 : 0));
        const float* mods_l = mods + (size_t)l * 5 * 9216;
        const bool first = (l == 0 && ph.b == 0);
        const float* in_lat = first ? P->in[I_X] : P->out; const float* in_ctx = first ? P->in[I_CTX] : XC;
        switch (ph.type) {
        case PH_PREP_A: EN(PH_PREP_A) prep_a(P, (LAS float*)lds); break;
        case PH_PREP_B: EN(PH_PREP_B) prep_b(P); break;
        case PH_CONV_NORM: EN(PH_CONV_NORM)
            conv_weights(P, l, (LAS float*)lds);
            norm_rows(in_lat, in_ctx, ph.a, P->in[I_NORMG] + (size_t)(l * 3 + 0) * 1024, mods_l, 0, 1, H, PART, nkpend, XC); break;
        case PH_NORM: EN(PH_NORM) { const int j = ph.b;
            norm_rows(P->out, XC, ph.a, P->in[I_NORMG] + (size_t)(l * 3 + j) * 1024, mods_l, j == 1 ? 3 : 6, j == 1 ? 4 : 7, H, PART, nkpend, XC); } break;
        case PH_F1: EN(PH_F1) { EpiSwiglu E; E.O = ACT; run_gemm(lds, H, W1 + (size_t)ph.b * 5632 * 1024, ph.a, 5632, 1024, E); } break;
        case PH_F2: EN(PH_F2) { EpiResid E; E.in_lat = in_lat; E.in_ctx = in_ctx; E.out_lat = dry ? dry_out : P->out; E.out_ctx = dry ? dry_out + (size_t)TLAT * D : XC; E.gate = mods_l + (ph.b == 0 ? 2 : 8) * 1024; E.scale = 0.5f;
            run_gemm(lds, ACT, W2 + (size_t)ph.b * 1024 * DFF, TLAT, 1024, DFF, E);
            if (ph.a > TLAT) ctx_splitk(lds, ACT + (size_t)TLAT * DFF, W2 + (size_t)ph.b * 1024 * DFF, DFF, PART, mods_l + (size_t)4 * 9216 + (ph.b == 0 ? 2 : 8) * 1024, 0.5f); } break;
        case PH_E1: EN(PH_E1) { EpiBf16Out E; E.O0 = (bf16_t*)(big + B_U); E.ld0 = 512; E.nt0 = 2; E.O1 = (bf16_t*)(big + B_PR); E.ld1 = 2048;
            run_gemm(lds, H, (const bf16_t*)(WM + WM_EWIN), TT, 2560, 1024, E); } break;
        case PH_FEAT: EN(PH_FEAT) feat_phase(P, i); break;
        case PH_E3: EN(PH_E3) { EpiLora E; E.EA = (bf16_t*)(big + B_PR); E.G = (bf16_t*)(big + B_G); E.w0 = P->in[I_EW0] + (size_t)i * 1024; E.a0 = P->in[I_EA0] + (size_t)i * 1024;
            run_gemm(lds, (const bf16_t*)(big + B_LORA), (const bf16_t*)(WM + WM_ELORA), TT, 2560, 384, E); } break;
        case PH_SCAN: EN(PH_SCAN) scan_phase(P, i, lds); break;
        case PH_READ: EN(PH_READ) read_phase(P, i, ph.a); break;
        case PH_GLU: EN(PH_GLU) { EpiGlu E; E.YG = (const bf16_t*)(big + B_YS); E.YCAT = H; E.bglu = P->in[I_EBGLU] + (size_t)i * 512;
            run_gemm(lds, (const bf16_t*)(big + B_YS), (const bf16_t*)(WM + WM_EGLU), ph.a, 512, 512, E); } break;
        case PH_EOUT: EN(PH_EOUT) { EpiResid E; E.in_lat = P->out; E.in_ctx = XC; E.out_lat = dry ? dry_out : P->out; E.out_ctx = dry ? dry_out + (size_t)TLAT * D : XC; E.gate = mods_l + 5 * 1024; E.scale = 1.0f;
            run_gemm(lds, H, (const bf16_t*)(WM + WM_EOUT), TLAT, 1024, 1024, E);
            if (ph.a > TLAT) ctx_splitk(lds, H + (size_t)TLAT * D, (const bf16_t*)(WM + WM_EOUT), 1024, PART, mods_l + (size_t)4 * 9216 + 5 * 1024, 1.0f); } break;
        case PH_O1: EN(PH_O1) { EpiBf16Out E; E.O0 = (bf16_t*)(big + B_PT); E.ld0 = TT; E.nt0 = 1 << 20; E.O1 = E.O0; E.ld1 = TT;
            run_gemm(lds, (const bf16_t*)(WM + WM_OWIN), H, 3072, ph.a, 1024, E, WGM_SWAPPED); } break;
        case PH_HY: EN(PH_HY) hyena_phase(P, i, ph.a > TLAT, lds); break;
        case PH_TR: EN(PH_TR) tr_phase(P, ph.a, lds); break;
        case PH_OOUT: EN(PH_OOUT) { EpiResid E; E.in_lat = P->out; E.in_ctx = XC; E.out_lat = dry ? dry_out : P->out; E.out_ctx = dry ? dry_out + (size_t)TLAT * D : XC; E.gate = mods_l + 5 * 1024; E.scale = 1.0f;
            run_gemm(lds, H, (const bf16_t*)(WM + WM_OOUT), TLAT, 1024, 1024, E);
            if (ph.a > TLAT) ctx_splitk(lds, H + (size_t)TLAT * D, (const bf16_t*)(WM + WM_OOUT), 1024, PART, mods_l + (size_t)4 * 9216 + 5 * 1024, 1.0f); } break;
        case PH_FINAL: EN(PH_FINAL) final_phase(P); break;
        default: break;
        }
        if (ip + 1 < p1) { if (p1 < 0) grid.sync(); else xcd_barrier(xb); }
    }
}

#ifndef MULTI_LAUNCH
#define MULTI_LAUNCH 0
#endif
extern "C" void kernel_launch(void* const* d_in, const int* in_sizes, int n_in, void* d_out, int out_size, void* d_ws, size_t ws_size, hipStream_t stream) {
    static int grid = 0;
    if (grid == 0) {
        if (n_in != N_IN || ws_size < WS_END) { fprintf(stderr, "kernel_launch: unexpected n_in %d / ws_size %zu (need %zu)\n", n_in, ws_size, (size_t)WS_END); grid = -1; return; }
        if (hipFuncSetAttribute((const void*)mega, hipFuncAttributeMaxDynamicSharedMemorySize, LDS_BYTES) != hipSuccess) { fprintf(stderr, "hipFuncSetAttribute failed\n"); grid = -1; return; }
        int dev = 0, cus = 0, per_cu = 0;
        hipGetDevice(&dev); hipDeviceGetAttribute(&cus, hipDeviceAttributeMultiprocessorCount, dev);
        hipOccupancyMaxActiveBlocksPerMultiprocessor(&per_cu, (const void*)mega, NTHREADS, LDS_BYTES);
        (void)hipGetLastError();
        if (per_cu < 1) per_cu = 1;
        grid = cus > 256 ? 256 : cus;
    }
    if (grid < 0) return;
    Params P; memset(&P, 0, sizeof(P));
    for (int k = 0; k < N_IN; ++k) P.in[k] = (const float*)d_in[k];
    P.out = (float*)d_out; P.ws = (char*)d_ws;
    int n = 0;
    auto add1 = [&](int type, int l, int a, int b) { P.ph[n].type = type; P.ph[n].l = l; P.ph[n].a = a; P.ph[n].b = b; ++n; };
    auto add = [&](int type, int l, int a, int b) { if ((DUP_MASK >> type) & 1u) add1(type, l, a, b | 0x100); add1(type, l, a, b); };
    add(PH_PREP_A, 0, 0, 0); add(PH_PREP_B, 0, 0, 1);
    int pend = 0;
    for (int l = 0; l < 4; ++l) {
        const int ra = l <= 2 ? TT : TLAT, ro = l < 2 ? TT : TLAT;
        add(PH_CONV_NORM, l, ra, 0 | (pend << 12)); pend = 0;
        add(PH_F1, l, ra, 0); add(PH_F2, l, ra, 0); if (ra > TLAT) pend = 11;
        add(PH_NORM, l, ra, 1 | (pend << 12)); pend = 0;
        if ((l & 1) == 0) { add(PH_E1, l, TT, 1); add(PH_FEAT, l, TT, 1); add(PH_E3, l, TT, 1); add(PH_SCAN, l, TT, 1); add(PH_READ, l, ro, 1); add(PH_GLU, l, ro, 1); add(PH_EOUT, l, ro, 1); }
        else { add(PH_O1, l, ro, 1); add(PH_HY, l, ro, 1); add(PH_TR, l, ro, 1); add(PH_OOUT, l, ro, 1); }
        if (ro > TLAT) pend = 4;
        add(PH_NORM, l, ro, 2 | (pend << 12)); pend = 0;
        add(PH_F1, l, ro, 1); add(PH_F2, l, ro, 1); if (ro > TLAT) pend = 11;
    }
    for (int k = 0; k < NOP_COUNT; ++k) add1(99, 0, 0, 1);
    add(PH_FINAL, 4, 0, 1);
    P.nph = n;
#if MULTI_LAUNCH
    for (int k = 0; k < n; ++k) { hipLaunchKernelGGL(mega, dim3(grid), dim3(NTHREADS), LDS_BYTES, stream, P, k, k + 1); }
#else
    (void)hipMemsetAsync(d_ws, 0, 16384, stream);
    int p0 = 0, p1 = n; void* args[] = {(void*)&P, (void*)&p0, (void*)&p1};
    hipError_t e = hipLaunchCooperativeKernel((const void*)mega, dim3(grid), dim3(NTHREADS), args, LDS_BYTES, stream);
    if (e != hipSuccess) fprintf(stderr, "cooperative launch failed: %s (grid %d)\n", hipGetErrorString(e), grid);
#endif
}
```
